# Optimizing an MI355X kernel written in HIP

```python
import math
import jax, jax.numpy as jnp
from jax import lax
import numpy as np

D_MODEL = 1024
BATCH = 32
SEQ = 2048
DEPTH = 2

FOX_HEADS = 4
FOX_HEAD_DIM = 64
MOBA_HEADS = 4
MOBA_HEAD_DIM = 64
MOBA_BLOCK = 256
MOBA_TOPK = 3
MOBA_Q_CHUNK = 32
MLA_HEADS = 8
MLA_NOPE_DIM = 64
MLA_ROPE_DIM = 32
MLA_V_DIM = 64
MLA_Q_RANK = 256
MLA_KV_RANK = 128
ROPE_THETA = 10000.0
T5_BUCKETS = 32
T5_MAX_DISTANCE = 128
Q_BLOCK = 128
D_FF = -(-8 * D_MODEL // (3 * 256)) * 256
RMS_EPS = 1e-6

FOX_W = FOX_HEADS * FOX_HEAD_DIM
MOBA_W = MOBA_HEADS * MOBA_HEAD_DIM
MLA_W = MLA_HEADS * MLA_V_DIM
MIX_WIDTH = FOX_W + MOBA_W + MLA_W
IN_SIZES = (FOX_W, FOX_W, FOX_W, FOX_HEADS, MOBA_W, MOBA_W, MOBA_W, MLA_Q_RANK, MLA_KV_RANK, MLA_ROPE_DIM)
IN_WIDTH = 3 * FOX_W + FOX_HEADS + 3 * MOBA_W + MLA_Q_RANK + MLA_KV_RANK + MLA_ROPE_DIM

kernel_name = 'hybrid_fox_moba_mla_block'


def rmsnorm(x, g):
    x32 = x.astype(jnp.float32)
    y = x32 * lax.rsqrt(jnp.mean(x32 * x32, axis=-1, keepdims=True) + RMS_EPS)
    return (y * g.astype(jnp.float32)).astype(x.dtype)


def rope(x, pos):
    half = x.shape[-1] // 2
    inv_freq = 1.0 / (ROPE_THETA ** (jnp.arange(half, dtype=jnp.float32) / half))
    ang = pos.astype(jnp.float32)[:, None] * inv_freq[None, :]
    cos, sin = jnp.cos(ang), jnp.sin(ang)
    x32 = x.astype(jnp.float32)
    x1, x2 = x32[..., :half], x32[..., half:]
    return jnp.concatenate([x1 * cos - x2 * sin, x2 * cos + x1 * sin], axis=-1).astype(x.dtype)


def t5_bucket(dist):
    n = jnp.maximum(dist, 0)
    max_exact = T5_BUCKETS // 2
    nf = jnp.maximum(n, max_exact).astype(jnp.float32)
    large = max_exact + (jnp.log(nf / max_exact) / math.log(T5_MAX_DISTANCE / max_exact)
                         * (T5_BUCKETS - max_exact)).astype(jnp.int32)
    large = jnp.minimum(large, T5_BUCKETS - 1)
    return jnp.where(n < max_exact, n, large)


def dense_causal_attention(q, k, v, log_decay_cum=None):
    B, H, S, dk = q.shape
    dv = v.shape[-1]
    nqb = S // Q_BLOCK
    scale = dk ** -0.5
    kpos = jnp.arange(S)
    q_blocks = q.reshape(B, H, nqb, Q_BLOCK, dk).transpose(2, 0, 1, 3, 4)
    starts = jnp.arange(nqb, dtype=jnp.int32) * Q_BLOCK
    if log_decay_cum is None:
        xs = (q_blocks, starts)
    else:
        xs = (q_blocks, starts, log_decay_cum.reshape(B, H, nqb, Q_BLOCK).transpose(2, 0, 1, 3))

    def step(blk):
        q_i, t0 = blk[0], blk[1]
        s = jnp.einsum('bhqd,bhkd->bhqk', q_i, k).astype(jnp.float32) * scale
        if log_decay_cum is not None:
            s = s + blk[2][..., None] - log_decay_cum[:, :, None, :]
        qpos = t0 + jnp.arange(Q_BLOCK)
        s = jnp.where(kpos[None, :] <= qpos[:, None], s, -jnp.inf)
        p = jax.nn.softmax(s, axis=-1)
        return jnp.einsum('bhqk,bhkd->bhqd', p.astype(v.dtype), v)

    out = lax.map(step, xs)
    return out.transpose(1, 2, 0, 3, 4).reshape(B, H, S, dv)


def moba_attention(q, k, v, t5_table):
    B, H, S, d = q.shape
    nb = -(-S // MOBA_BLOCK)
    s_pad = nb * MOBA_BLOCK
    n_sel = min(MOBA_TOPK, nb)
    scale = d ** -0.5
    pad = ((0, 0), (0, 0), (0, s_pad - S), (0, 0))
    k_blocks = jnp.pad(k, pad).reshape(B, H, nb, MOBA_BLOCK, d)
    v_blocks = jnp.pad(v, pad).reshape(B, H, nb, MOBA_BLOCK, d)
    k_mean = jnp.mean(k_blocks.astype(jnp.float32), axis=3)
    qpos = jnp.arange(S)
    gate = jnp.einsum('bhsd,bhnd->bhsn', q.astype(jnp.float32), k_mean)
    past = jnp.arange(nb)[None, :] < (qpos // MOBA_BLOCK)[:, None]
    gate = jnp.where(past, gate, -jnp.inf)
    _, sel = lax.top_k(gate, n_sel)

    nc = S // MOBA_Q_CHUNK
    q_c = q.reshape(B, H, nc, MOBA_Q_CHUNK, d).transpose(2, 0, 1, 3, 4)
    sel_c = sel.reshape(B, H, nc, MOBA_Q_CHUNK, n_sel).transpose(2, 0, 1, 3, 4)
    starts = jnp.arange(nc, dtype=jnp.int32) * MOBA_Q_CHUNK
    table_t = t5_table.T
    b_ix = jnp.arange(B)[:, None, None, None]
    h_ix = jnp.arange(H)[None, :, None, None]
    offs = jnp.arange(MOBA_BLOCK)

    def step(blk):
        q_i, sel_i, t0 = blk
        own = t0 // MOBA_BLOCK
        qp = t0 + jnp.arange(MOBA_Q_CHUNK)
        k_g = k_blocks[b_ix, h_ix, sel_i]
        v_g = v_blocks[b_ix, h_ix, sel_i]
        kp_sel = sel_i[..., None] * MOBA_BLOCK + offs
        bias_sel = table_t[h_ix[..., None], t5_bucket(qp[:, None, None] - kp_sel)]
        s_sel = jnp.einsum('bhqd,bhqnkd->bhqnk', q_i, k_g).astype(jnp.float32) * scale + bias_sel
        s_sel = jnp.where((sel_i < own)[..., None], s_sel, -jnp.inf)
        k_own = lax.dynamic_index_in_dim(k_blocks, own, axis=2, keepdims=False)
        v_own = lax.dynamic_index_in_dim(v_blocks, own, axis=2, keepdims=False)
        dist_own = qp[:, None] - (own * MOBA_BLOCK + offs)[None, :]
        s_own = (jnp.einsum('bhqd,bhkd->bhqk', q_i, k_own).astype(jnp.float32) * scale
                 + table_t[:, t5_bucket(dist_own)])
        s_own = jnp.where(dist_own >= 0, s_own, -jnp.inf)
        n_flat = n_sel * MOBA_BLOCK
        s = jnp.concatenate([s_sel.reshape(B, H, MOBA_Q_CHUNK, n_flat), s_own], axis=-1)
        p = jax.nn.softmax(s, axis=-1).astype(v.dtype)
        p_sel = p[..., :n_flat].reshape(B, H, MOBA_Q_CHUNK, n_sel, MOBA_BLOCK)
        p_own = p[..., n_flat:]
        return (jnp.einsum('bhqnk,bhqnkd->bhqd', p_sel, v_g)
                + jnp.einsum('bhqk,bhkd->bhqd', p_own, v_own))

    out = lax.map(step, (q_c, sel_c, starts))
    return out.transpose(1, 2, 0, 3, 4).reshape(B, H, S, d)


def hybrid_mixer(h, w_in, b_forget, g_q_lat, w_uq, g_kv_lat, w_ukv, g_group, w_out, t5_table):
    B, S, _ = h.shape
    proj = h @ w_in
    split_points = np.cumsum(IN_SIZES)[:-1].tolist()
    q_f, k_f, v_f, f_logit, q_m, k_m, v_m, c_q, c_kv, k_r = jnp.split(proj, split_points, axis=-1)

    def heads(t, n):
        return t.reshape(B, S, n, -1).transpose(0, 2, 1, 3)

    def flat(o):
        return o.transpose(0, 2, 1, 3).reshape(B, S, -1)

    pos = jnp.arange(S)
    log_f = jax.nn.log_sigmoid((f_logit + b_forget).astype(jnp.float32))
    F = jnp.cumsum(log_f, axis=1).transpose(0, 2, 1)
    o_f = dense_causal_attention(heads(q_f, FOX_HEADS), heads(k_f, FOX_HEADS), heads(v_f, FOX_HEADS), F)
    o_m = moba_attention(heads(q_m, MOBA_HEADS), heads(k_m, MOBA_HEADS), heads(v_m, MOBA_HEADS), t5_table)
    q_lat = heads(rmsnorm(c_q, g_q_lat) @ w_uq, MLA_HEADS)
    q_nope, q_rot = q_lat[..., :MLA_NOPE_DIM], q_lat[..., MLA_NOPE_DIM:]
    kv = heads(rmsnorm(c_kv, g_kv_lat) @ w_ukv, MLA_HEADS)
    k_nope, v_c = kv[..., :MLA_NOPE_DIM], kv[..., MLA_NOPE_DIM:]
    k_rot = rope(k_r[:, None], pos)
    q_c = jnp.concatenate([q_nope, rope(q_rot, pos)], axis=-1)
    k_c = jnp.concatenate([k_nope, jnp.broadcast_to(k_rot, (B, MLA_HEADS, S, MLA_ROPE_DIM))], axis=-1)
    o_c = dense_causal_attention(q_c, k_c, v_c)
    g_a, g_b, g_c = jnp.split(g_group, [FOX_W, FOX_W + MOBA_W])
    o = jnp.concatenate([rmsnorm(flat(o_f), g_a), rmsnorm(flat(o_m), g_b), rmsnorm(flat(o_c), g_c)], axis=-1)
    return o @ w_out


def swiglu(h, w_gate_up, w_down):
    g, u = jnp.split(h @ w_gate_up, 2, axis=-1)
    return (jax.nn.silu(g) * u) @ w_down


def setup_inputs(seed: int = 0) -> dict:
    key = jax.random.key(seed)
    ks = jax.random.split(key, 20)
    f32 = jnp.float32

    def nrm(k, shape, scale):
        return jax.random.normal(k, shape, f32) * scale

    def gain(k, shape):
        return 1.0 + 0.1 * jax.random.normal(k, shape, f32)

    L = DEPTH
    return {
        'x': nrm(ks[0], (BATCH, SEQ, D_MODEL), 1.0),
        'c': nrm(ks[1], (BATCH, D_MODEL), 1.0),
        't5_table': nrm(ks[2], (T5_BUCKETS, MOBA_HEADS), 0.5),
        'w_ada': nrm(ks[3], (L, D_MODEL, 6 * D_MODEL), D_MODEL ** -0.5),
        'b_ada': nrm(ks[4], (L, 6 * D_MODEL), 0.02),
        'g_mix_pre': gain(ks[5], (L, D_MODEL)),
        'g_mix_post': gain(ks[6], (L, D_MODEL)),
        'w_in': nrm(ks[7], (L, D_MODEL, IN_WIDTH), D_MODEL ** -0.5),
        'b_forget': 2.0 + 0.5 * jax.random.normal(ks[8], (L, FOX_HEADS), f32),
        'g_q_lat': gain(ks[9], (L, MLA_Q_RANK)),
        'w_uq': nrm(ks[10], (L, MLA_Q_RANK, MLA_HEADS * (MLA_NOPE_DIM + MLA_ROPE_DIM)), MLA_Q_RANK ** -0.5),
        'g_kv_lat': gain(ks[11], (L, MLA_KV_RANK)),
        'w_ukv': nrm(ks[12], (L, MLA_KV_RANK, MLA_HEADS * (MLA_NOPE_DIM + MLA_V_DIM)), MLA_KV_RANK ** -0.5),
        'g_group': gain(ks[13], (L, MIX_WIDTH)),
        'w_out': nrm(ks[14], (L, MIX_WIDTH, D_MODEL), MIX_WIDTH ** -0.5),
        'g_ffn_pre': gain(ks[15], (L, D_MODEL)),
        'g_ffn_post': gain(ks[16], (L, D_MODEL)),
        'w_gate_up': nrm(ks[17], (L, D_MODEL, 2 * D_FF), D_MODEL ** -0.5),
        'w_down': nrm(ks[18], (L, D_FF, D_MODEL), D_FF ** -0.5),
    }


def reference(x, c, t5_table, w_ada, b_ada, g_mix_pre, g_mix_post, w_in, b_forget, g_q_lat, w_uq,
              g_kv_lat, w_ukv, g_group, w_out, g_ffn_pre, g_ffn_post, w_gate_up, w_down):
    c_act = jax.nn.silu(c)
    for l in range(DEPTH):
        mod = (c_act @ w_ada[l] + b_ada[l])[:, None, :]
        shift_a, scale_a, gate_a, shift_f, scale_f, gate_f = jnp.split(mod, 6, axis=-1)
        h = rmsnorm(x, g_mix_pre[l]) * (1.0 + scale_a) + shift_a
        y = hybrid_mixer(h, w_in[l], b_forget[l], g_q_lat[l], w_uq[l], g_kv_lat[l], w_ukv[l],
                         g_group[l], w_out[l], t5_table)
        x = x + gate_a * rmsnorm(y, g_mix_post[l])
        h = rmsnorm(x, g_ffn_pre[l]) * (1.0 + scale_f) + shift_f
        x = x + gate_f * rmsnorm(swiglu(h, w_gate_up[l], w_down[l]), g_ffn_post[l])
    return x
```

```cpp
#include <hip/hip_runtime.h>
#include <cstdio>
#include <cstdint>
namespace pg8 {
#define PG8_LAS __attribute__((address_space(3)))
typedef unsigned short bf16_t;
typedef short bf16x8 __attribute__((ext_vector_type(8)));
typedef float f32x4 __attribute__((ext_vector_type(4)));
typedef unsigned u32x4 __attribute__((ext_vector_type(4)));
typedef int i32x8 __attribute__((ext_vector_type(8)));
__device__ __forceinline__ const char* uptr(const char* p) { const unsigned long long v = (unsigned long long)p;
    const unsigned lo = (unsigned)__builtin_amdgcn_readfirstlane((int)(unsigned)v), hi = (unsigned)__builtin_amdgcn_readfirstlane((int)(unsigned)(v >> 32)); return (const char*)(((unsigned long long)hi << 32) | lo); }
__device__ __forceinline__ void mfma_f8_inplace(f32x4& c, i32x8 a, i32x8 b) { asm volatile("v_mfma_f32_16x16x128_f8f6f4 %0, %1, %2, %0" : "+v"(c) : "v"(a), "v"(b)); }
template <bool OFFS> __device__ __forceinline__ auto tile_pos(const char* base) { if constexpr (OFFS) return 0u; else return base; }
__device__ __forceinline__ void glds_sa(unsigned voff, const void* sbase, unsigned lds_dst) { unsigned keep;
    asm volatile("s_mov_b32 %0, m0\n\ts_mov_b32 m0, %2\n\ts_nop 0\n\tglobal_load_lds_dwordx4 %1, %3\n\ts_mov_b32 m0, %0" : "=&s"(keep) : "v"(voff), "s"(lds_dst), "s"(sbase) : "memory"); }
constexpr int BM = 256, BK = 64, HALF = 128, HTB = HALF * BK * 2  , STAGE_BYTES = 8 * HTB, NXCD = 8, WGM = 8;

__host__ __device__ __forceinline__ int lds_byte(int r, int c) { const int st = (r >> 4) * 2 + (c >> 5), rr = r & 15, cc = c & 31, ob = rr * 64 + cc * 2; return st * 1024 + (ob ^ (((ob >> 9) & 1) << 5)); }
__host__ __device__ __forceinline__ void stage_rc(int b, int& R, int& C) { const int st = b / 1024, sb = b % 1024, swz = sb ^ (((sb >> 9) & 1) << 5); R = (st >> 1) * 16 + swz / 64; C = (st & 1) * 32 + (swz % 64) / 2; }
__host__ __device__ __forceinline__ int perm32(int rho) { const int n = rho >> 4, i = rho & 15; return 8 * (i >> 2) + 4 * n + (i & 3); }

struct Unit { int pm, pn; };
struct Gemm { const bf16_t* A; const bf16_t* Bt; int M, N, K; };

struct StaticOrder {
    int nM, nN, nwg, G, c;
    __host__ __device__ void init(int M, int N, int G_, int c_) { nM = M / BM; nN = N / BM; nwg = nM * nN; G = G_; c = c_; }
    __host__ __device__ bool next(int i, Unit& u) const {
        const long L = (long)i * G + c; if (L >= nwg) return false;
        int wgid = (int)L; { const int q = nwg / NXCD, r = nwg % NXCD, xcd = wgid % NXCD, off = wgid / NXCD; wgid = (xcd < r ? xcd * (q + 1) : r * (q + 1) + (xcd - r) * q) + off; }
        const int nig = WGM * nN, gid = wgid / nig, fm = gid * WGM, gsz = (nM - fm) < WGM ? (nM - fm) : WGM;
        u.pm = fm + ((wgid % nig) % gsz); u.pn = (wgid % nig) / gsz; return true;
    }
    __device__ __forceinline__ void a_ready(const Unit&) const {}
    __device__ __forceinline__ void done(const Unit&) const {}
};

__device__ __forceinline__ unsigned cvt_pk_bf16(float lo, float hi) { unsigned r; asm volatile("v_cvt_pk_bf16_f32 %0, %1, %2" : "=v"(r) : "v"(lo), "v"(hi)); return r; }
typedef float f32x2 __attribute__((ext_vector_type(2)));
template <class Epi, class Sched, bool ALIGN_EPI = false, bool SP2 = false, bool F8 = false, bool SA = F8>
__device__ __forceinline__ void gemm_phase(PG8_LAS unsigned char* lds, const Gemm g, const Sched& S, const Epi& E) {
    int tid = threadIdx.x; asm volatile("" : "+v"(tid));
    const int wid = __builtin_amdgcn_readfirstlane(tid >> 6), lane = tid & 63, wr = wid >> 2, wc = wid & 3, fr = lane & 15, fq = lane >> 4;
    const int K = g.K, nt = K / BK;
    unsigned voffA[2], voffB[2];
#pragma unroll
    for (int i = 0; i < 2; ++i) { int R, C; stage_rc(tid * 16 + i * 8192, R, C); const int Rb = Epi::PERM ? ((R & ~31) + perm32(R & 31)) : R;
        voffA[i] = (unsigned)(R * K + C) * 2u; voffB[i] = (unsigned)(Rb * K + C) * 2u; }
    const unsigned kstep = (unsigned)(BK * 2);
    const unsigned hstep = (unsigned)HALF * (unsigned)K * 2u;
    const unsigned tstep = 2u * hstep;
    const unsigned ldsu = (unsigned)__builtin_amdgcn_readfirstlane((int)((unsigned)(uintptr_t)lds + (unsigned)wid * 1024u)); (void)ldsu;
    const unsigned ldsw = (unsigned)wid * 1024u;
    const int aoff = lds_byte(wr * 64 + fr, fq * 8), boff = lds_byte(wc * 32 + fr, fq * 8);
#define PG8_SA(b, h) (((b) * 2 + (h)) * HTB)
#define PG8_SB(b, h) ((4 + (b) * 2 + (h)) * HTB)
#define PG8_HOF(bufoff) (((((bufoff) / HTB) & 1) != 0) ? hstep : 0u)
#define PG8_STAGE(bufoff, gbase, voff) do { _Pragma("unroll") for (int _i = 0; _i < 2; ++_i) { \
        if constexpr (SA) glds_sa((voff)[_i] + (gbase), ((bufoff) < 4 * HTB) ? (((((bufoff) / HTB) & 1) != 0) ? gAh : gA) : (((((bufoff) / HTB) & 1) != 0) ? gBh : gB), ldsu + (unsigned)((bufoff) + _i * 8192)); \
        else __builtin_amdgcn_global_load_lds((const unsigned*)((gbase) + PG8_HOF(bufoff) + (voff)[_i]), (PG8_LAS unsigned*)(lds + (bufoff) + ldsw + _i * 8192), 16, 0, 0); } } while (0)
#define PG8_LDA(dst, b, h) do { _Pragma("unroll") for (int m = 0; m < 4; ++m) _Pragma("unroll") for (int k = 0; k < 2; ++k) dst[m][k] = *(const PG8_LAS bf16x8*)(lds + PG8_SA(b, h) + aoff + m * 2048 + k * 1024); } while (0)
#define PG8_LDB(dst, b, h) do { _Pragma("unroll") for (int n = 0; n < 2; ++n) _Pragma("unroll") for (int k = 0; k < 2; ++k) dst[n][k] = *(const PG8_LAS bf16x8*)(lds + PG8_SB(b, h) + boff + n * 2048 + k * 1024); } while (0)
#define PG8_CAT(x) __builtin_bit_cast(i32x8, __builtin_shufflevector((x)[0], (x)[1], 0, 1, 2, 3, 4, 5, 6, 7, 8, 9, 10, 11, 12, 13, 14, 15))
#define PG8_MMA(ai, bj, At, Bt) do { __builtin_amdgcn_s_setprio(1); _Pragma("unroll") for (int m = 0; m < 4; ++m) _Pragma("unroll") for (int n = 0; n < 2; ++n) { \
        if constexpr (F8) mfma_f8_inplace(acc[ai][bj][m][n], PG8_CAT(Bt[n]), PG8_CAT(At[m])); \
        else { _Pragma("unroll") for (int k = 0; k < 2; ++k) acc[ai][bj][m][n] = __builtin_amdgcn_mfma_f32_16x16x32_bf16(Bt[n][k], At[m][k], acc[ai][bj][m][n], 0, 0, 0); } } __builtin_amdgcn_s_setprio(0); } while (0)
#define PG8_WAIT_V(n) asm volatile("s_waitcnt vmcnt(" #n ")" ::: "memory")
#define PG8_WAIT_L(n) asm volatile("s_waitcnt lgkmcnt(" #n ")" ::: "memory")
#define PG8_BAR __builtin_amdgcn_s_barrier()
#define PG8_SCHED __builtin_amdgcn_sched_barrier(0)
    const char* const gA = uptr((const char*)g.A); const char* const gB = uptr((const char*)g.Bt); const char* const gAh = uptr((const char*)g.A + hstep); const char* const gBh = uptr((const char*)g.Bt + hstep); (void)gA; (void)gB; (void)gAh; (void)gBh;
    using TP = __typeof__(tile_pos<SA>((const char*)nullptr));
    Unit cur, nxt; int ui = 0;
    if (!S.next(0, cur)) return;
    cur.pm = __builtin_amdgcn_readfirstlane(cur.pm); cur.pn = __builtin_amdgcn_readfirstlane(cur.pn);
    f32x4 acc[2][2][4][2];
#pragma unroll
    for (int a = 0; a < 2; ++a)
#pragma unroll
        for (int b = 0; b < 2; ++b)
#pragma unroll
            for (int m = 0; m < 4; ++m)
#pragma unroll
                for (int n = 0; n < 2; ++n) acc[a][b][m][n] = (f32x4){0.f, 0.f, 0.f, 0.f};
    bf16x8 At[4][2], B0[2][2], B1[2][2];
    TP cA = tile_pos<SA>((const char*)g.A) + (unsigned)cur.pm * tstep; TP cB = tile_pos<SA>((const char*)g.Bt) + (unsigned)cur.pn * tstep;
    S.a_ready(cur);
    if constexpr (Epi::KSCALE) E.prep(cur, 0, wid, lane);
    if constexpr (SP2) {
        PG8_STAGE(PG8_SB(0, 0), cB, voffB); PG8_STAGE(PG8_SB(0, 1), cB, voffB); PG8_STAGE(PG8_SA(0, 0), cA, voffA); PG8_STAGE(PG8_SA(0, 1), cA, voffA);
        if (wr == 1) PG8_BAR;
        PG8_WAIT_V(2); PG8_BAR;
        PG8_STAGE(PG8_SB(1, 0), cB + kstep, voffB); PG8_STAGE(PG8_SA(1, 0), cA + kstep, voffA); PG8_STAGE(PG8_SB(1, 1), cB + kstep, voffB);
        PG8_WAIT_V(6); PG8_BAR;
    } else {
        PG8_STAGE(PG8_SB(0, 0), cB, voffB); PG8_STAGE(PG8_SA(0, 0), cA, voffA); PG8_STAGE(PG8_SB(0, 1), cB, voffB); PG8_STAGE(PG8_SA(0, 1), cA, voffA);
        if (wr == 1) PG8_BAR;
        PG8_WAIT_V(4); PG8_BAR;
        PG8_STAGE(PG8_SB(1, 0), cB + kstep, voffB); PG8_STAGE(PG8_SA(1, 0), cA + kstep, voffA); PG8_STAGE(PG8_SB(1, 1), cB + kstep, voffB);
        PG8_WAIT_V(6); PG8_BAR;
    }
    for (;;) {
        const bool has_next = S.next(ui + 1, nxt);
        nxt.pm = __builtin_amdgcn_readfirstlane(nxt.pm); nxt.pn = __builtin_amdgcn_readfirstlane(nxt.pn);
        const TP nA = has_next ? tile_pos<SA>((const char*)g.A) + (unsigned)nxt.pm * tstep : cA; const TP nB = has_next ? tile_pos<SA>((const char*)g.Bt) + (unsigned)nxt.pn * tstep : cB;
#pragma unroll 1
        for (int t = 0; t < nt; t += 2) {
            const bool last = (t == nt - 2);
            const TP a1 = cA + (unsigned)(t + 1) * kstep;
            const TP a2 = last ? nA : cA + (unsigned)(t + 2) * kstep; const TP b2 = last ? nB : cB + (unsigned)(t + 2) * kstep;
            const TP a3 = a2 + kstep; const TP b3 = b2 + kstep;
            if (last && has_next) { S.a_ready(nxt); if constexpr (Epi::KSCALE) E.prep(nxt, (ui + 1) & 1, wid, lane); }
            if constexpr (Epi::KSCALE) { if (t == 4 || t == 8) E.kscale(acc, ui & 1, t == 4 ? 0 : 1, wr, fr); }
            if constexpr (SP2) {
            PG8_LDB(B0, 0, 0); PG8_LDB(B1, 0, 1); PG8_SCHED; PG8_LDA(At, 0, 0); PG8_STAGE(PG8_SA(1, 1), a1, voffA);
            PG8_WAIT_V(8); PG8_WAIT_L(0); PG8_BAR; PG8_MMA(0, 0, At, B0); PG8_MMA(0, 1, At, B1); PG8_BAR; PG8_SCHED;
            PG8_LDA(At, 0, 1); PG8_STAGE(PG8_SB(0, 0), b2, voffB); PG8_STAGE(PG8_SB(0, 1), b2, voffB); PG8_STAGE(PG8_SA(0, 0), a2, voffA);
            PG8_WAIT_V(8); PG8_WAIT_L(0); PG8_BAR; PG8_MMA(1, 0, At, B0); PG8_MMA(1, 1, At, B1); PG8_BAR; PG8_SCHED;
            PG8_LDB(B0, 1, 0); PG8_LDB(B1, 1, 1); PG8_SCHED; PG8_LDA(At, 1, 0); PG8_STAGE(PG8_SA(0, 1), a2, voffA);
            PG8_WAIT_V(8); PG8_WAIT_L(0); PG8_BAR; PG8_MMA(0, 0, At, B0); PG8_MMA(0, 1, At, B1); PG8_BAR; PG8_SCHED;
            PG8_LDA(At, 1, 1); PG8_STAGE(PG8_SB(1, 0), b3, voffB); PG8_STAGE(PG8_SB(1, 1), b3, voffB); PG8_STAGE(PG8_SA(1, 0), a3, voffA);
            PG8_WAIT_V(8); PG8_WAIT_L(0); PG8_BAR; PG8_MMA(1, 0, At, B0); PG8_MMA(1, 1, At, B1); PG8_BAR; PG8_SCHED;
            } else {
            PG8_LDB(B0, 0, 0); PG8_SCHED; PG8_LDA(At, 0, 0); PG8_STAGE(PG8_SA(1, 1), a1, voffA);
            PG8_WAIT_L(8); PG8_BAR; PG8_WAIT_L(0); PG8_MMA(0, 0, At, B0); PG8_BAR; PG8_SCHED;
            PG8_LDB(B1, 0, 1); PG8_STAGE(PG8_SB(0, 0), b2, voffB);
            PG8_BAR; PG8_WAIT_L(0); PG8_MMA(0, 1, At, B1); PG8_BAR;
            PG8_LDA(At, 0, 1); PG8_STAGE(PG8_SA(0, 0), a2, voffA);
            PG8_BAR; PG8_WAIT_L(0); PG8_MMA(1, 0, At, B0); PG8_BAR; PG8_SCHED;
            PG8_STAGE(PG8_SB(0, 1), b2, voffB);
            PG8_WAIT_V(6); PG8_BAR; PG8_MMA(1, 1, At, B1); PG8_BAR;
            PG8_LDB(B0, 1, 0); PG8_SCHED; PG8_LDA(At, 1, 0); PG8_STAGE(PG8_SA(0, 1), a2, voffA);
            PG8_WAIT_L(8); PG8_BAR; PG8_WAIT_L(0); PG8_MMA(0, 0, At, B0); PG8_BAR; PG8_SCHED;
            PG8_LDB(B1, 1, 1); PG8_STAGE(PG8_SB(1, 0), b3, voffB);
            PG8_BAR; PG8_WAIT_L(0); PG8_MMA(0, 1, At, B1); PG8_BAR;
            PG8_LDA(At, 1, 1); PG8_STAGE(PG8_SA(1, 0), a3, voffA);
            PG8_BAR; PG8_WAIT_L(0); PG8_MMA(1, 0, At, B0); PG8_BAR; PG8_SCHED;
            PG8_STAGE(PG8_SB(1, 1), b3, voffB);
            PG8_WAIT_V(6); PG8_BAR; PG8_MMA(1, 1, At, B1); PG8_BAR;
            }
        }
        if constexpr (F8) asm volatile("s_nop 15\n\ts_nop 15" ::: "memory");
        if constexpr (ALIGN_EPI) { if (wr == 0) PG8_BAR; }
        if constexpr (Epi::KSCALE) E.kscale(acc, ui & 1, 2, wr, fr);
        if constexpr (!Epi::AFTER_DRAIN) { E(acc, cur, wr, wc, fr, fq); S.done(cur); }
        if (!has_next) break;
#pragma unroll
        for (int a = 0; a < 2; ++a)
#pragma unroll
            for (int b = 0; b < 2; ++b)
#pragma unroll
                for (int m = 0; m < 4; ++m)
#pragma unroll
                    for (int n = 0; n < 2; ++n) acc[a][b][m][n] = (f32x4){0.f, 0.f, 0.f, 0.f};
        cur = nxt; cA = nA; cB = nB; ++ui;
        if constexpr (ALIGN_EPI) { if (wr == 1) PG8_BAR; }
    }
    PG8_WAIT_V(0);
    if constexpr (!ALIGN_EPI) { if (wr == 0) PG8_BAR; }
    PG8_BAR;
    if constexpr (Epi::AFTER_DRAIN) { E.fused(acc, cur, wr, wc, fr, fq, lds, wid, lane); S.done(cur); }
#undef PG8_SA
#undef PG8_SB
#undef PG8_STAGE
#undef PG8_HOF
#undef PG8_LDA
#undef PG8_LDB
#undef PG8_MMA
#undef PG8_CAT
#undef PG8_WAIT_V
#undef PG8_WAIT_L
#undef PG8_BAR
#undef PG8_SCHED
}
}
#define LAS __attribute__((address_space(3)))
#define XB_TMO      128
#define XB_XCNT(j)  (256  + 64 * (j))
#define XB_XSUB(j)  (1280 + 64 * (j))
#define XB_XGEN(j)  (2304 + 64 * (j))
#define XB_TOP      3328
#define XB_TOPGEN   3392
#define XCD_BAR_WORDS 3456
#define XB_SPIN_CAP (1u << 18)

__device__ __forceinline__ unsigned xb_ld(unsigned* p)              { return __hip_atomic_load(p, __ATOMIC_RELAXED, __HIP_MEMORY_SCOPE_AGENT); }
__device__ __forceinline__ unsigned xb_add(unsigned* p, unsigned v) { return __hip_atomic_fetch_add(p, v, __ATOMIC_RELAXED, __HIP_MEMORY_SCOPE_AGENT); }
__device__ __forceinline__ unsigned xb_xcc_id() { return (unsigned)__builtin_amdgcn_s_getreg((3 << 11) | 20) & 0xFu; }
#define XB_SPIN(cond, bar) do { unsigned _sp = 0; while (cond) { __builtin_amdgcn_s_sleep(1); \
    if ((++_sp & 255u) == 0u) { if (xb_ld(&(bar)[XB_TMO])) break; if (_sp > XB_SPIN_CAP) { atomicAdd(&(bar)[XB_TMO], 1u); break; } } } } while (0)

struct XcdBarrier {
    unsigned* bar; unsigned x;
    volatile LAS unsigned* st;
};

__device__ __forceinline__ XcdBarrier xcd_barrier_post(unsigned* bar, volatile LAS unsigned* st) {
    XcdBarrier b; b.bar = bar; b.x = xb_xcc_id(); b.st = st;
    if (threadIdx.x == 0) (void)xb_add(&bar[XB_XCNT(b.x)], 1u);
    return b;
}
__device__ __forceinline__ void xcd_barrier_complete(unsigned* bar, unsigned x, unsigned& nloc, unsigned& nx) {
    const unsigned G = gridDim.x * gridDim.y * gridDim.z;
    unsigned sum, cnt, mine, sp = 0u;
    for (;;) {
        sum = 0u; cnt = 0u; mine = 0u;
#pragma unroll
        for (unsigned j = 0; j < 16; ++j) { const unsigned c = xb_ld(&bar[XB_XCNT(j)]); sum += c; cnt += (c > 0u) ? 1u : 0u; mine = (j == x) ? c : mine; }
        if (sum == G) break;
        __builtin_amdgcn_s_sleep(1);
        if ((++sp & 255u) == 0u) { if (xb_ld(&bar[XB_TMO])) break; if (sp > XB_SPIN_CAP) { atomicAdd(&bar[XB_TMO], 1u); break; } }
    }
    nloc = mine > 0u ? mine : 1u; nx = cnt > 0u ? cnt : 1u;
}

__device__ __forceinline__ void xcd_barrier(const XcdBarrier& b) {
    asm volatile("s_waitcnt vmcnt(0)" ::: "memory");
    __syncthreads();
    if (threadIdx.x == 0) {
        unsigned* bar = b.bar;
        __builtin_amdgcn_s_waitcnt(0);
        unsigned nloc = b.st[0], nx = b.st[1];
        if (nloc == 0u) { xcd_barrier_complete(bar, b.x, nloc, nx); b.st[0] = nloc; b.st[1] = nx; }
        const unsigned old = xb_add(&bar[XB_XSUB(b.x)], 1u);
        const unsigned gen = old / nloc;
        if (old + 1u == (gen + 1u) * nloc) {
            __builtin_amdgcn_fence(__ATOMIC_RELEASE, "agent");
            asm volatile("s_waitcnt vmcnt(0)" ::: "memory");
            const unsigned og = xb_add(&bar[XB_TOP], 1u);
            const unsigned tg = og / nx;
            if (og + 1u == (tg + 1u) * nx) xb_add(&bar[XB_TOPGEN], 1u);
            else XB_SPIN(xb_ld(&bar[XB_TOPGEN]) == tg, bar);
            __builtin_amdgcn_fence(__ATOMIC_ACQUIRE, "agent");
            xb_add(&bar[XB_XGEN(b.x)], 1u);
            asm volatile("s_waitcnt vmcnt(0)" ::: "memory");
        } else {
            XB_SPIN(xb_ld(&bar[XB_XGEN(b.x)]) == gen, bar);
            __builtin_amdgcn_fence(__ATOMIC_ACQUIRE, "agent");
            asm volatile("s_waitcnt vmcnt(0)" ::: "memory");
        }
    }
    __syncthreads();
}
#ifndef MK_FUSED
#define MK_FUSED 1
#endif
constexpr int NB = 32, SEQ = 2048, DM = 1024, MTOK = NB * SEQ, NLAYER = 2, DFF = 2816, IN_W = 1956;
constexpr float RMS_EPS = 1e-6f, LOG2E = 1.4426950408889634f;
constexpr float C2_64 = 0.125f * LOG2E, C2_96 = 0.10206207261596577f * LOG2E;
constexpr int NWAVES = 8, NTHR = 512;
typedef float f32x2 __attribute__((ext_vector_type(2)));
typedef float f32x16 __attribute__((ext_vector_type(16)));
typedef unsigned u32x2 __attribute__((ext_vector_type(2)));

constexpr size_t MiB = 1u << 20;
constexpr size_t WS_CTL = 0, CTL_ZERO_BYTES = 1 * MiB;
constexpr size_t WS_CMOD = 1 * MiB;
constexpr size_t WS_ROPE = 3 * MiB;
constexpr size_t WS_TB = 3 * MiB + 512 * 1024;
constexpr size_t WS_PSUM = 3 * MiB + 512 * 1024 + 4096;
constexpr size_t WS_KMP = 4 * MiB;
constexpr size_t WS_LOGF = 5 * MiB;
constexpr size_t WS_CQSS = 6 * MiB;
constexpr size_t WS_CKVSS = 7 * MiB;
constexpr size_t WS_YSS = 8 * MiB;
constexpr size_t WS_OSS = 12 * MiB;
constexpr size_t WS_KMF = WS_YSS;
constexpr size_t WS_F = WS_LOGF;
constexpr size_t WS_W = 16 * MiB, W_LAYER = 24 * MiB;
constexpr size_t WO_IN = 0, WO_UQ = 4 * MiB, WO_UKV = 4 * MiB + 512 * 1024, WO_OUT = 5 * MiB, WO_GU = 7 * MiB, WO_DN = 18 * MiB;
constexpr size_t WS_H = 64 * MiB;
constexpr size_t WS_QF = 192 * MiB, WS_KF = 232 * MiB, WS_VF = 272 * MiB, WS_QM = 304 * MiB, WS_KM = 336 * MiB, WS_VM = 368 * MiB;
constexpr size_t WS_CQ = 400 * MiB, WS_T7 = 432 * MiB, WS_QC = 464 * MiB, WS_KC = 560 * MiB, WS_VC = 656 * MiB;
constexpr size_t WS_ACT = 192 * MiB;
constexpr size_t WS_ACT8 = 544 * MiB;
constexpr size_t WS_DN8 = 976 * MiB, DN8_LAYER = 3 * MiB;
constexpr int PM8_L0 = 256, PM8_L1 = 256;
constexpr float ACT_SC = 4.f, WDN_SC = 512.f, DN_OSC = 1.f / (ACT_SC * WDN_SC);
constexpr size_t WS_KR = 624 * MiB;
constexpr size_t WS_O = 720 * MiB, WS_Y = WS_H  , WS_XB = 848 * MiB  , WS_END = 982 * MiB;
constexpr int CW_BAR = 4096;

constexpr int RING_BYTES = 131072, MISC_OFF = RING_BYTES + 320, LDS_BYTES = 147456;

#define GAS __attribute__((address_space(1)))
typedef unsigned short bf16;
typedef unsigned v4u __attribute__((ext_vector_type(4)));
typedef pg8::f32x4 f32x4;
typedef pg8::bf16x8 bf16x8;
#define LDS_WAIT() asm volatile("s_waitcnt lgkmcnt(0)" ::: "memory")
#define VM_WAIT() asm volatile("s_waitcnt vmcnt(0)" ::: "memory")

typedef __bf16 bf16x2_t __attribute__((ext_vector_type(2)));
__device__ __forceinline__ unsigned pk2(float lo, float hi) { f32x2 v = {lo, hi}; bf16x2_t b = __builtin_convertvector(v, bf16x2_t); return __builtin_bit_cast(unsigned, b); }
__device__ __forceinline__ float bf2f(unsigned short h) { return __uint_as_float((unsigned)h << 16); }
__device__ __forceinline__ unsigned short f2bf1(float f) { return (unsigned short)(pk2(f, 0.f) & 0xffffu); }
__device__ __forceinline__ v4u pack8(f32x4 a, f32x4 b) { v4u w; w.x = pk2(a[0], a[1]); w.y = pk2(a[2], a[3]); w.z = pk2(b[0], b[1]); w.w = pk2(b[2], b[3]); return w; }
template <int CTRL> __device__ __forceinline__ float dpp_mov(float v) { return __int_as_float(__builtin_amdgcn_update_dpp(0, __float_as_int(v), CTRL, 0xF, 0xF, true)); }
__device__ __forceinline__ float sum8(float v) { v += dpp_mov<0xB1>(v); v += dpp_mov<0x4E>(v); v += dpp_mov<0x141>(v); return v; }
__device__ __forceinline__ float sum16(float v) { v = sum8(v); v += dpp_mov<0x140>(v); return v; }
__device__ __forceinline__ float sum_rows(float v) {
    auto a = __builtin_amdgcn_permlane16_swap(__float_as_uint(v), __float_as_uint(v), false, false); v = __uint_as_float(a[0]) + __uint_as_float(a[1]);
    auto b = __builtin_amdgcn_permlane32_swap(__float_as_uint(v), __float_as_uint(v), false, false); return __uint_as_float(b[0]) + __uint_as_float(b[1]); }
__device__ __forceinline__ float wave_sum(float v) { return sum_rows(sum16(v)); }
__device__ __forceinline__ float other_half(float v, int upper) {
    auto b = __builtin_amdgcn_permlane32_swap(__float_as_uint(v), __float_as_uint(v), false, false); return __uint_as_float(upper ? b[0] : b[1]); }
__device__ __forceinline__ float fast_rsqrt(float x) { return __builtin_amdgcn_rsqf(x); }

__device__ __forceinline__ unsigned char* ws_at(unsigned char* base, unsigned long long off) { asm volatile("" : "+s"(off)); return base + off; }
__device__ __forceinline__ int map_src(int map, int n) {
    if (map == 0) {
        const int t = n >> 8, c = n & 255;
        if (t < 3) return t * 256 + c;
        if (t < 6) return 772 + (t - 3) * 256 + c;
        if (t == 6) return 1540 + c;
        if (c < 128) return 1796 + c;
        if (c < 160) return 1924 + (c - 128);
        if (c < 164) return 768 + (c - 160);
        return -1;
    }
    if (map == 2) { const int t = n >> 8, c = n & 255; return c < 128 ? 128 * t + c : DFF + 128 * t + (c - 128); }
    return n;
}
__device__ __forceinline__ void prep_item(const float* W, int Ksrc, int Nsrc, bf16* WT, int Kdst, int map, const float* kscale, LAS float* scr, int kb, int nb, int lane) {
    const int k0 = 64 * kb, n0 = 32 * nb;
    const int sc = map_src(map, n0 + (lane & 31));
    float wv[32];
#pragma unroll
    for (int i = 0; i < 32; ++i) { const int k = k0 + 2 * i + (lane >> 5); wv[i] = (sc >= 0 && k < Ksrc) ? W[(size_t)k * Nsrc + sc] : 0.f; }
    if (kscale) {
#pragma unroll
        for (int i = 0; i < 32; ++i) { const int k = k0 + 2 * i + (lane >> 5); if (k < Ksrc) wv[i] *= kscale[k]; } }
    const float nsc = (map == 3) ? WDN_SC : (map == 2) ? ((((n0 + (lane & 31)) & 255) < 128) ? -1.4426950408889634f : -0.6931471805599453f * ACT_SC) : 1.f;
#pragma unroll
    for (int i = 0; i < 32; ++i) scr[(2 * i + (lane >> 5)) * 33 + (lane & 31)] = wv[i] * nsc;
    LDS_WAIT(); asm volatile("" ::: "memory");
    const int c = lane & 7;
#pragma unroll
    for (int j = 0; j < 4; ++j) { const int n = (lane >> 3) + 8 * j; const LAS float* s = scr + (8 * c) * 33 + n;
        v4u o; o.x = pk2(s[0 * 33], s[1 * 33]); o.y = pk2(s[2 * 33], s[3 * 33]); o.z = pk2(s[4 * 33], s[5 * 33]); o.w = pk2(s[6 * 33], s[7 * 33]);
        *(GAS v4u*)(WT + (size_t)(n0 + n) * Kdst + k0 + 8 * c) = o; }
    LDS_WAIT(); asm volatile("" ::: "memory");
}

__device__ __forceinline__ void prep_item8(const float* W, int Nsrc, unsigned char* WT, int Kdst, float sc, LAS float* scr, int kb, int nb, int lane) {
    const int k0 = 64 * kb, n0 = 32 * nb;
    float wv[32];
#pragma unroll
    for (int i = 0; i < 32; ++i) wv[i] = W[(size_t)(k0 + 2 * i + (lane >> 5)) * Nsrc + n0 + (lane & 31)];
#pragma unroll
    for (int i = 0; i < 32; ++i) scr[(2 * i + (lane >> 5)) * 33 + (lane & 31)] = wv[i] * sc;
    LDS_WAIT(); asm volatile("" ::: "memory");
    const int c = lane & 3;
#pragma unroll
    for (int j = 0; j < 2; ++j) { const int n = (lane >> 2) + 16 * j; const LAS float* s = scr + (16 * c) * 33 + n; v4u o;
#pragma unroll
        for (int q = 0; q < 4; ++q) { int w = __builtin_amdgcn_cvt_pk_fp8_f32(s[(4 * q) * 33], s[(4 * q + 1) * 33], 0, false); w = __builtin_amdgcn_cvt_pk_fp8_f32(s[(4 * q + 2) * 33], s[(4 * q + 3) * 33], w, true); o[q] = (unsigned)w; }
        *(GAS v4u*)(WT + (size_t)(n0 + n) * Kdst + k0 + 16 * c) = o; }
    LDS_WAIT(); asm volatile("" ::: "memory");
}

__device__ __forceinline__ int t5_bucket_dev(int n) {
    if (n < 16) return n;
    int c = 15;
    c += (n >= 16); c += (n >= 19); c += (n >= 21); c += (n >= 24); c += (n >= 27); c += (n >= 31); c += (n >= 35); c += (n >= 40);
    c += (n >= 46); c += (n >= 52); c += (n >= 59); c += (n >= 67); c += (n >= 77); c += (n >= 87); c += (n >= 99); c += (n >= 113);
    return c;
}
__device__ __forceinline__ void sincos_acc(float ang, float& c, float& s) {
    const double a = (double)ang; const double q = __builtin_rint(a * 0.63661977236758134308); const double r = __builtin_fma(-q, 1.57079632679489661923, a) - q * 6.123233995736766e-17;
    const double r2 = r * r;
    double sp = -7.6471637318198164759e-13; sp = sp * r2 + 1.6059043836821614599e-10; sp = sp * r2 - 2.5052108385441718775e-08; sp = sp * r2 + 2.7557319223985890653e-06;
    sp = sp * r2 - 1.9841269841269841270e-04; sp = sp * r2 + 8.3333333333333333333e-03; sp = sp * r2 - 1.6666666666666666667e-01; const double sn = r + r * r2 * sp;
    double cp = 4.7794773323873852974e-14; cp = cp * r2 - 1.1470745597729724714e-11; cp = cp * r2 + 2.0876756987868098979e-09; cp = cp * r2 - 2.7557319223985890653e-07;
    cp = cp * r2 + 2.4801587301587301587e-05; cp = cp * r2 - 1.3888888888888888889e-03; cp = cp * r2 + 4.1666666666666666667e-02; cp = cp * r2 - 0.5; const double cs = 1.0 + r2 * cp;
    const int qi = ((int)q) & 3;
    const double cc = (qi == 0) ? cs : (qi == 1) ? -sn : (qi == 2) ? -cs : sn;
    const double ss = (qi == 0) ? sn : (qi == 1) ? cs : (qi == 2) ? -sn : -cs;
    c = (float)cc; s = (float)ss;
}
__device__ __forceinline__ float rope_invfreq(int i) {
    const float t[16] = {0x1.000000p+0f, 0x1.1feb34p-1f, 0x1.43d136p-2f, 0x1.6c310ep-3f, 0x1.99999ap-4f, 0x1.ccab84p-5f, 0x1.030dc6p-5f, 0x1.235a72p-6f, 0x1.47ae14p-7f, 0x1.708938p-8f, 0x1.9e7c70p-9f, 0x1.d22a50p-10f, 0x1.0624dep-10f, 0x1.26d42cp-11f, 0x1.4b96c0p-12f, 0x1.74eea6p-13f};
    float r = t[0];
#pragma unroll
    for (int k = 1; k < 16; ++k) r = (i == k) ? t[k] : r;
    return r;
}

constexpr int RPI = 4;
__device__ __forceinline__ f32x4 bf4_to_f32(u32x2 w) { f32x4 r; r.x = __uint_as_float(w.x << 16); r.y = __uint_as_float(w.x & 0xffff0000u); r.z = __uint_as_float(w.y << 16); r.w = __uint_as_float(w.y & 0xffff0000u); return r; }
__device__ __forceinline__ float sq4(f32x4 v) { return (v.x * v.x + v.y * v.y) + (v.z * v.z + v.w * v.w); }
__device__ __forceinline__ void prenorm_rows(const float* x, const float* cmod_l  , int ipre, int ish, bf16* H, int gw, int NGW, int lane) {
    for (int ch = gw; ch < MTOK / 32; ch += NGW) {
        const int m0 = ch * 32, b = m0 >> 11;
        const GAS f32x4* prep = (const GAS f32x4*)(cmod_l + ((size_t)b * 6 + ipre) * DM) + lane;
        const GAS f32x4* shp = (const GAS f32x4*)(cmod_l + ((size_t)b * 6 + ish) * DM) + lane;
        f32x4 pre[4], sh[4];
#pragma unroll
        for (int j = 0; j < 4; ++j) { pre[j] = prep[64 * j]; sh[j] = shp[64 * j]; }
#pragma unroll 1
        for (int i = 0; i < 32; i += RPI) {
            f32x4 v[RPI][4];
#pragma unroll
            for (int r = 0; r < RPI; ++r) { const GAS f32x4* xr = (const GAS f32x4*)(x + (size_t)(m0 + i + r) * DM) + lane;
#pragma unroll
                for (int j = 0; j < 4; ++j) v[r][j] = __builtin_nontemporal_load(xr + 64 * j); }
#pragma unroll
            for (int r = 0; r < RPI; ++r) {
                const float rstd = fast_rsqrt(wave_sum((sq4(v[r][0]) + sq4(v[r][1])) + (sq4(v[r][2]) + sq4(v[r][3]))) * (1.f / DM) + RMS_EPS);
                GAS u32x2* o8 = (GAS u32x2*)(H + (size_t)(m0 + i + r) * DM) + lane;
#pragma unroll
                for (int j = 0; j < 4; ++j) { const f32x4 q = v[r][j] * rstd * pre[j] + sh[j]; u32x2 w; w.x = pk2(q.x, q.y); w.y = pk2(q.z, q.w); o8[64 * j] = w; }
            }
        }
    }
}
template <bool XIN_BF, bool XOUT_BF>
__device__ __forceinline__ void post_rows(const void* xin_, void* xout_, const bf16* Y, const float* YSS, float yeps, const float* cmod_l, int ipost,
                                          bool do_pre, const float* cmod_n, int ipre, int ish, bf16* H, int gw, int NGW, int lane) {
    constexpr int RP = XIN_BF ? 8 : RPI;
    const unsigned l8 = (unsigned)lane * 8u, l16 = (unsigned)lane * 16u;
#define LD8(base, j) __builtin_nontemporal_load((const GAS u32x2*)((const GAS char*)(base) + (l8 + (j) * 512u)))
#define LD16(base, j) __builtin_nontemporal_load((const GAS f32x4*)((const GAS char*)(base) + (l16 + (j) * 1024u)))
    for (int ch = gw; ch < MTOK / 32; ch += NGW) {
        const int m0 = ch * 32, b = m0 >> 11;
        const float* pop = cmod_l + ((size_t)b * 6 + ipost) * DM; const float* prep = cmod_n + ((size_t)b * 6 + ipre) * DM; const float* shp = cmod_n + ((size_t)b * 6 + ish) * DM;
        f32x4 po[4], pre[4], sh[4];
#pragma unroll
        for (int j = 0; j < 4; ++j) { po[j] = *(const GAS f32x4*)((const GAS char*)pop + (l16 + j * 1024u)); pre[j] = do_pre ? *(const GAS f32x4*)((const GAS char*)prep + (l16 + j * 1024u)) : po[j]; sh[j] = do_pre ? *(const GAS f32x4*)((const GAS char*)shp + (l16 + j * 1024u)) : po[j]; }
#pragma unroll 1
        for (int i = 0; i < 32; i += RP) {
            f32x4 xf[XIN_BF ? 1 : RP][4]; u32x2 xb[XIN_BF ? RP : 1][4]; u32x2 yw[RP][4]; float rsy[RP];
#pragma unroll
            for (int r = 0; r < RP; ++r) { const size_t m = (size_t)(m0 + i + r);
                const bf16* yrow = Y + m * DM;
                if (XIN_BF) { const bf16* xrow = (const bf16*)xin_ + m * DM;
#pragma unroll
                    for (int j = 0; j < 4; ++j) { xb[XIN_BF ? r : 0][j] = LD8(xrow, j); yw[r][j] = LD8(yrow, j); } }
                else { const float* xrow = (const float*)xin_ + m * DM;
#pragma unroll
                    for (int j = 0; j < 4; ++j) { xf[XIN_BF ? 0 : r][j] = LD16(xrow, j); yw[r][j] = LD8(yrow, j); } }
                const GAS f32x4* ssp = (const GAS f32x4*)(YSS + m * 16);
                const f32x4 s0 = ssp[0], s1 = ssp[1], s2 = ssp[2], s3 = ssp[3];
                rsy[r] = ((s0.x + s0.y) + (s0.z + s0.w)) + ((s1.x + s1.y) + (s1.z + s1.w)) + ((s2.x + s2.y) + (s2.z + s2.w)) + ((s3.x + s3.y) + (s3.z + s3.w)); }
#pragma unroll
            for (int r = 0; r < RP; ++r) { const size_t m = (size_t)(m0 + i + r);
                const float ry = fast_rsqrt(rsy[r] * (1.f / DM) + yeps);
                float s = 0.f; f32x4 v[4];
#pragma unroll
                for (int j = 0; j < 4; ++j) { const f32x4 xv = XIN_BF ? bf4_to_f32(xb[XIN_BF ? r : 0][j]) : xf[XIN_BF ? 0 : r][j];
                    v[j] = xv + po[j] * bf4_to_f32(yw[r][j]) * ry; s += sq4(v[j]);
                    if (XOUT_BF) { u32x2 w; w.x = pk2(v[j].x, v[j].y); w.y = pk2(v[j].z, v[j].w); __builtin_nontemporal_store(w, (GAS u32x2*)((GAS char*)((bf16*)xout_ + m * DM) + (l8 + j * 512u))); }
                    else __builtin_nontemporal_store(v[j], (GAS f32x4*)((GAS char*)((float*)xout_ + m * DM) + (l16 + j * 1024u))); }
                if (do_pre) {
                    const float rstd = fast_rsqrt(wave_sum(s) * (1.f / DM) + RMS_EPS);
                    bf16* hrow = H + m * DM;
#pragma unroll
                    for (int j = 0; j < 4; ++j) { const f32x4 q = v[j] * rstd * pre[j] + sh[j]; u32x2 w; w.x = pk2(q.x, q.y); w.y = pk2(q.z, q.w); *(GAS u32x2*)((GAS char*)hrow + (l8 + j * 512u)) = w; }
                }
            }
        }
    }
#undef LD8
#undef LD16
}
template <int DKP, int NH>
__device__ __forceinline__ unsigned hm_off(int row, int head, int d) { return (unsigned)((((row >> 11) * NH + head) * SEQ + (row & (SEQ - 1))) * DKP + d); }
__device__ __forceinline__ void fox_scan(const float* LOGF, const float* PSUM, bf16* QF, bf16* KF, int gw, int NGW, int lane, LAS float* scr  ) {
    for (int task = gw; task < (MTOK / 256) * 4; task += NGW) {
        const int pm = task >> 2, h = task & 3, b = pm >> 3;
        float carry = 0.f;
        for (int p = b * 8; p < pm; ++p) carry += PSUM[(p * 2) * 4 + h] + PSUM[(p * 2 + 1) * 4 + h];
        const float* src = LOGF + ((size_t)pm * 256 + 4 * lane) * 4 + h;
        float lv[4];
#pragma unroll
        for (int i = 0; i < 4; ++i) lv[i] = src[4 * i];
        scr[lane] = (lv[0] + lv[1]) + (lv[2] + lv[3]); LDS_WAIT(); asm volatile("" ::: "memory");
        float run = carry;
#pragma unroll 16
        for (int i = 0; i < 64; ++i) { const float tv = scr[i]; run += (i < lane) ? tv : 0.f; }
        LDS_WAIT(); asm volatile("" ::: "memory");
        const v4u z = {0u, 0u, 0u, 0u}; v4u q0; q0.x = 0x3f803f80u; q0.y = 0x00003f80u; q0.z = 0u; q0.w = 0u;
        const int row = pm * 256 + 4 * lane;
        const unsigned ko = hm_off<80, 4>(row, h, 64), qo = (unsigned)(row * 320 + h * 80 + 64);
#pragma unroll
        for (int i = 0; i < 4; ++i) {
            run += lv[i];
            const float v = -run;
            const float b1 = bf2f(f2bf1(v)); const float r1 = v - b1; const float b2 = bf2f(f2bf1(r1)); const float r2 = r1 - b2;
            v4u k0; k0.x = pk2(b1, b2); k0.y = pk2(r2, 0.f); k0.z = 0u; k0.w = 0u;
            *(GAS v4u*)(KF + (ko + i * 80u)) = k0; *(GAS v4u*)(KF + (ko + i * 80u + 8u)) = z;
            *(GAS v4u*)(QF + (qo + i * 320u)) = q0; *(GAS v4u*)(QF + (qo + i * 320u + 8u)) = z;
        }
    }
}

__device__ __forceinline__ void glds16(const void* gsrc, unsigned lds_dst) { unsigned keep;
    asm volatile("s_mov_b32 %0, m0\n\ts_mov_b32 m0, %2\n\ts_nop 0\n\tglobal_load_lds_dwordx4 %1, off\n\ts_mov_b32 m0, %0" : "=&s"(keep) : "v"(gsrc), "s"(lds_dst) : "memory"); }
__device__ __forceinline__ void build_kmf(const float* KMP, bf16* KMF, int gw, int NGW, int lane) {
    const int r32 = lane & 31, hi = lane >> 5;
    for (int t4 = gw; t4 < NB * 4 * 4; t4 += NGW) { const int task = t4 >> 2, d0 = t4 & 3, b = task >> 2, h = task & 3;
        float v[8];
#pragma unroll
        for (int j = 0; j < 8; ++j) { v[j] = 0.f; if (r32 < 8) { const float* p = KMP + ((size_t)(b * 8 + r32) * 2) * 256 + h * 64 + 16 * d0 + 8 * hi + j; v[j] = p[0] + p[256]; } }
        v4u wh, wl; float l[8], hh[8];
#pragma unroll
        for (int j = 0; j < 8; ++j) { hh[j] = bf2f(f2bf1(v[j])); l[j] = v[j] - hh[j]; }
        wh.x = pk2(hh[0], hh[1]); wh.y = pk2(hh[2], hh[3]); wh.z = pk2(hh[4], hh[5]); wh.w = pk2(hh[6], hh[7]);
        wl.x = pk2(l[0], l[1]); wl.y = pk2(l[2], l[3]); wl.z = pk2(l[4], l[5]); wl.w = pk2(l[6], l[7]);
        *(GAS v4u*)(KMF + (((size_t)task * 2 + 0) * 4 + d0) * 512 + lane * 8) = wh;
        *(GAS v4u*)(KMF + (((size_t)task * 2 + 1) * 4 + d0) * 512 + lane * 8) = wl;
    }
}
using pg8::Unit;
template <int HEADPITCH>
__device__ __forceinline__ void store_bf16_tile(const f32x4 (&acc)[2][2][4][2], bf16* base, int pitch, int row0, int ct0, float sc) {
#pragma unroll
    for (int ai = 0; ai < 2; ++ai)
#pragma unroll
        for (int m = 0; m < 4; ++m) { bf16* rowp = base + (size_t)(row0 + ai * 128 + m * 16) * pitch;
#pragma unroll
            for (int bj = 0; bj < 2; ++bj) { const int ct = bj * 128 + ct0; const int col = HEADPITCH ? (ct >> 6) * HEADPITCH + (ct & 63) : ct;
                *(GAS v4u*)(rowp + col) = pack8(acc[ai][bj][m][0] * sc, acc[ai][bj][m][1] * sc); } }
}
struct EpiInproj {
    static constexpr bool PERM = true, AFTER_DRAIN = false, KSCALE = false;
    unsigned char* ws; const float* bfg;
    __device__ __forceinline__ void operator()(const f32x4 (&acc)[2][2][4][2], const Unit& u, int wr, int wc, int fr, int fq) const {
        unsigned char* wsl = ws; asm volatile("" : "+s"(wsl));
        bf16* const QF = (bf16*)ws_at(wsl, WS_QF); bf16* const KF = (bf16*)ws_at(wsl, WS_KF); bf16* const VF = (bf16*)ws_at(wsl, WS_VF); bf16* const QM = (bf16*)ws_at(wsl, WS_QM); bf16* const KM = (bf16*)ws_at(wsl, WS_KM);
        bf16* const VM = (bf16*)ws_at(wsl, WS_VM); bf16* const CQ = (bf16*)ws_at(wsl, WS_CQ); bf16* const T7 = (bf16*)ws_at(wsl, WS_T7); bf16* const KR = (bf16*)ws_at(wsl, WS_KR);
        float* const KMP = (float*)ws_at(wsl, WS_KMP); float* const CQSS = (float*)ws_at(wsl, WS_CQSS); float* const CKVSS = (float*)ws_at(wsl, WS_CKVSS); float* const LOGF = (float*)ws_at(wsl, WS_LOGF);
        const f32x2* const ROPE = (const f32x2*)ws_at(wsl, WS_ROPE);
        const int row0 = u.pm * 256 + wr * 64 + fr, ct0 = wc * 32 + 8 * fq;
        const int pn = u.pn;
        if (pn == 0) { store_bf16_tile<80>(acc, QF, 320, row0, ct0, C2_64); return; }
        if (pn == 1) {
            const int hd0 = ct0 >> 6, d = ct0 & 63;
#pragma unroll
            for (int ai = 0; ai < 2; ++ai)
#pragma unroll
                for (int m = 0; m < 4; ++m) { const unsigned off = hm_off<80, 4>(row0 + ai * 128 + m * 16, hd0, d);
                    *(GAS v4u*)(KF + off) = pack8(acc[ai][0][m][0], acc[ai][0][m][1]); *(GAS v4u*)(KF + (off + 2u * SEQ * 80u)) = pack8(acc[ai][1][m][0], acc[ai][1][m][1]);
                    if (m & 1) asm volatile("" ::: "memory"); }
            return; }
        if (pn == 2) { store_bf16_tile<0>(acc, VF, 256, row0, ct0, 1.f); return; }
        if (pn == 3) { store_bf16_tile<0>(acc, QM, 256, row0, ct0, C2_64); return; }
        if (pn == 5) { store_bf16_tile<0>(acc, VM, 256, row0, ct0, 1.f); return; }
        if (pn == 4) {
            store_bf16_tile<0>(acc, KM, 256, row0, ct0, 1.f);
#pragma unroll
            for (int bj = 0; bj < 2; ++bj)
#pragma unroll
                for (int n = 0; n < 2; ++n) { f32x4 s = {0.f, 0.f, 0.f, 0.f};
#pragma unroll
                    for (int ai = 0; ai < 2; ++ai)
#pragma unroll
                        for (int m = 0; m < 4; ++m) s += acc[ai][bj][m][n];
                    s.x = sum16(s.x); s.y = sum16(s.y); s.z = sum16(s.z); s.w = sum16(s.w);
                    if (fr == 0) *(GAS f32x4*)(KMP + ((size_t)u.pm * 2 + wr) * 256 + bj * 128 + ct0 + 4 * n) = s; }
            return;
        }
        if (pn == 6) {
            store_bf16_tile<0>(acc, CQ, 256, row0, ct0, 1.f);
#pragma unroll
            for (int ai = 0; ai < 2; ++ai)
#pragma unroll
                for (int m = 0; m < 4; ++m) { float s = 0.f;
#pragma unroll
                    for (int bj = 0; bj < 2; ++bj)
#pragma unroll
                        for (int n = 0; n < 2; ++n) { const f32x4 x = acc[ai][bj][m][n]; s += (x.x * x.x + x.y * x.y) + (x.z * x.z + x.w * x.w); }
                    s = sum_rows(s);
                    if (fq == 0) CQSS[(size_t)(row0 + ai * 128 + m * 16) * 4 + wc] = s; }
            return;
        }
#pragma unroll
        for (int ai = 0; ai < 2; ++ai)
#pragma unroll
            for (int m = 0; m < 4; ++m) *(GAS v4u*)(T7 + (unsigned)((row0 + ai * 128 + m * 16) * 128 + ct0)) = pack8(acc[ai][0][m][0], acc[ai][0][m][1]);
        f32x4 fsum = {0.f, 0.f, 0.f, 0.f};
#pragma unroll
        for (int ai = 0; ai < 2; ++ai)
#pragma unroll
            for (int m = 0; m < 4; ++m) { const int row = row0 + ai * 128 + m * 16; float s = 0.f;
#pragma unroll
                for (int n = 0; n < 2; ++n) { const f32x4 x = acc[ai][0][m][n]; s += (x.x * x.x + x.y * x.y) + (x.z * x.z + x.w * x.w); }
                s = sum_rows(s);
                if (fq == 0) CKVSS[(size_t)row * 4 + wc] = s;
                if (wc == 0) {
                    const int pos = row & (SEQ - 1); f32x4 o[2];
#pragma unroll
                    for (int n = 0; n < 2; ++n) { const f32x4 x = acc[ai][1][m][n]; f32x4 p;
                        p.x = other_half(x.x, fq >> 1); p.y = other_half(x.y, fq >> 1); p.z = other_half(x.z, fq >> 1); p.w = other_half(x.w, fq >> 1);
                        const int d = 8 * fq + 4 * n; const float sg = (fq < 2) ? -1.f : 1.f;
                        const GAS f32x2* cs = (const GAS f32x2*)ROPE + pos * 16 + (d & 15);
                        const f32x2 c0 = cs[0], c1 = cs[1], c2 = cs[2], c3 = cs[3];
                        o[n].x = x.x * c0.x + sg * p.x * c0.y; o[n].y = x.y * c1.x + sg * p.y * c1.y; o[n].z = x.z * c2.x + sg * p.z * c2.y; o[n].w = x.w * c3.x + sg * p.w * c3.y; }
                    const v4u w = pack8(o[0], o[1]);
                    *(GAS v4u*)(KR + (unsigned)(row * 32 + 8 * fq)) = w;
                }
                if (wc == 1 && fq == 0) {
                    const f32x4 x = acc[ai][1][m][0]; f32x4 r;
#pragma unroll
                    for (int j = 0; j < 4; ++j) { const float z = x[j] + bfg[j]; const float az = __builtin_fabsf(z);
                        r[j] = __builtin_fminf(z, 0.f) * LOG2E - __builtin_amdgcn_logf(1.f + __builtin_amdgcn_exp2f(-az * LOG2E)); }
                    *(GAS f32x4*)(LOGF + (size_t)row * 4) = r; fsum += r;
                }
            }
        if (wc == 1) { fsum.x = sum16(fsum.x); fsum.y = sum16(fsum.y); fsum.z = sum16(fsum.z); fsum.w = sum16(fsum.w);
            if (fq == 0 && fr == 0) *(GAS f32x4*)((float*)ws_at(wsl, WS_PSUM) + ((size_t)u.pm * 2 + wr) * 4) = fsum; }
    }
};
struct EpiQup {
    static constexpr bool PERM = true, AFTER_DRAIN = false, KSCALE = false;
    bf16* QC; const float* CQSS; const f32x2* ROPE;
    __device__ __forceinline__ void operator()(const f32x4 (&acc)[2][2][4][2], const Unit& u, int wr, int wc, int fr, int fq) const {
        const int row0 = u.pm * 256 + wr * 64 + fr;
        f32x4 ss[2][4]; float rstd[2][4];
#pragma unroll
        for (int ai = 0; ai < 2; ++ai)
#pragma unroll
            for (int m = 0; m < 4; ++m) ss[ai][m] = *(const GAS f32x4*)(CQSS + (size_t)(row0 + ai * 128 + m * 16) * 4);
#pragma unroll
        for (int ai = 0; ai < 2; ++ai)
#pragma unroll
            for (int m = 0; m < 4; ++m) rstd[ai][m] = fast_rsqrt(((ss[ai][m].x + ss[ai][m].y) + (ss[ai][m].z + ss[ai][m].w)) * (1.f / 256.f) + RMS_EPS);
        const int rbj = ((8 * u.pn + wc) % 3 == 2) ? 0 : (((8 * u.pn + 4 + wc) % 3 == 2) ? 1 : -1);
        const float sg = (fq < 2) ? -1.f : 1.f;
#pragma unroll
        for (int ai = 0; ai < 2; ++ai)
#pragma unroll
            for (int mp = 0; mp < 4; mp += 2) {
                f32x4 cs[2][4];
                if (rbj >= 0) {
#pragma unroll
                    for (int m2 = 0; m2 < 2; ++m2) { const int pos = (row0 + ai * 128 + (mp + m2) * 16) & (SEQ - 1); const GAS f32x4* cp = (const GAS f32x4*)((const GAS f32x2*)ROPE + pos * 16 + 8 * (fq & 1));
#pragma unroll
                        for (int q = 0; q < 4; ++q) cs[m2][q] = cp[q]; }
                }
#pragma unroll
                for (int m2 = 0; m2 < 2; ++m2) { const int m = mp + m2; const int row = row0 + ai * 128 + m * 16; const float rs = rstd[ai][m];
#pragma unroll
                    for (int bj = 0; bj < 2; ++bj) { f32x4 o[2];
#pragma unroll
                        for (int n = 0; n < 2; ++n) { const f32x4 x = acc[ai][bj][m][n] * rs;
                            if (bj == rbj) { f32x4 p; p.x = other_half(x.x, fq >> 1); p.y = other_half(x.y, fq >> 1); p.z = other_half(x.z, fq >> 1); p.w = other_half(x.w, fq >> 1);
                                const f32x4 c01 = cs[m2][2 * n], c23 = cs[m2][2 * n + 1];
                                o[n].x = x.x * c01.x + sg * p.x * c01.y; o[n].y = x.y * c01.z + sg * p.y * c01.w; o[n].z = x.z * c23.x + sg * p.z * c23.y; o[n].w = x.w * c23.z + sg * p.w * c23.w;
                            } else o[n] = x; }
                        *(GAS v4u*)(QC + (size_t)row * 768 + u.pn * 256 + bj * 128 + wc * 32 + 8 * fq) = pack8(o[0] * C2_96, o[1] * C2_96); } }
                asm volatile("" ::: "memory");
            }
    }
};
struct EpiKVup {
    static constexpr bool PERM = true, AFTER_DRAIN = false, KSCALE = false;
    bf16 *KC, *VC; const float* CKVSS;
    __device__ __forceinline__ void operator()(const f32x4 (&acc)[2][2][4][2], const Unit& u, int wr, int wc, int fr, int fq) const {
        const int row0 = u.pm * 256 + wr * 64 + fr;
        f32x4 ss[2][4]; float rstd[2][4];
#pragma unroll
        for (int ai = 0; ai < 2; ++ai)
#pragma unroll
            for (int m = 0; m < 4; ++m) ss[ai][m] = *(const GAS f32x4*)(CKVSS + (size_t)(row0 + ai * 128 + m * 16) * 4);
#pragma unroll
        for (int ai = 0; ai < 2; ++ai)
#pragma unroll
            for (int m = 0; m < 4; ++m) rstd[ai][m] = fast_rsqrt(((ss[ai][m].x + ss[ai][m].y) + (ss[ai][m].z + ss[ai][m].w)) * (1.f / 128.f) + RMS_EPS);
#pragma unroll
        for (int ai = 0; ai < 2; ++ai)
#pragma unroll
            for (int m = 0; m < 4; ++m) { const int row = row0 + ai * 128 + m * 16; const float rs = rstd[ai][m];
#pragma unroll
                for (int bj = 0; bj < 2; ++bj) { const int head = 2 * u.pn + bj, within = wc * 32 + 8 * fq;
                    const v4u w = pack8(acc[ai][bj][m][0] * rs, acc[ai][bj][m][1] * rs);
                    if (wc < 2) *(GAS v4u*)(KC + hm_off<64, 8>(row, head, within)) = w;
                    else *(GAS v4u*)(VC + (size_t)row * 512 + head * 64 + (within - 64)) = w; } }
    }
};
struct EpiY {
    static constexpr bool PERM = true, AFTER_DRAIN = false, KSCALE = false;
    bf16* Y; float* YSS;
    __device__ __forceinline__ void operator()(const f32x4 (&acc)[2][2][4][2], const Unit& u, int wr, int wc, int fr, int fq) const {
        asm volatile("" : "+v"(fr), "+v"(fq));
        const int row0 = u.pm * 256 + wr * 64 + fr, ct0 = wc * 32 + 8 * fq;
#pragma unroll
        for (int ai = 0; ai < 2; ++ai)
#pragma unroll
            for (int m = 0; m < 4; ++m) { const int row = row0 + ai * 128 + m * 16; float s = 0.f;
#pragma unroll
                for (int bj = 0; bj < 2; ++bj) {
#pragma unroll
                    for (int n = 0; n < 2; ++n) { const f32x4 x = acc[ai][bj][m][n]; s += (x.x * x.x + x.y * x.y) + (x.z * x.z + x.w * x.w); }
                    *(GAS v4u*)(Y + (unsigned)(row * DM + u.pn * 256 + bj * 128 + ct0)) = pack8(acc[ai][bj][m][0], acc[ai][bj][m][1]); }
                s = sum_rows(s);
                if (fq == 0) YSS[(unsigned)(row * 16 + u.pn * 4 + wc)] = s; }
    }
};
struct EpiYks {
    static constexpr bool PERM = true, AFTER_DRAIN = false, KSCALE = true;
    bf16* Y; float* YSS; const float* F; LAS float* tab;
    __device__ __forceinline__ void prep(const Unit& u, int par, int wid, int lane) const {
        if (wid < 4) glds16(F + ((size_t)u.pm * 256 + wid * 64 + lane) * 4, (unsigned)__builtin_amdgcn_readfirstlane((unsigned)(uintptr_t)tab + par * 4096 + wid * 1024)); }
    __device__ __forceinline__ void kscale(f32x4 (&acc)[2][2][4][2], int par, int which, int wr, int fr) const {
#pragma unroll
        for (int ai = 0; ai < 2; ++ai)
#pragma unroll
            for (int m = 0; m < 4; ++m) { const float s = tab[par * 1024 + (ai * 128 + wr * 64 + m * 16 + fr) * 4 + which];
#pragma unroll
                for (int bj = 0; bj < 2; ++bj)
#pragma unroll
                    for (int n = 0; n < 2; ++n) acc[ai][bj][m][n] *= s; } }
    __device__ __forceinline__ void operator()(const f32x4 (&acc)[2][2][4][2], const Unit& u, int wr, int wc, int fr, int fq) const {
        const int row0 = u.pm * 256 + wr * 64 + fr, ct0 = wc * 32 + 8 * fq;
#pragma unroll
        for (int ai = 0; ai < 2; ++ai)
#pragma unroll
            for (int m = 0; m < 4; ++m) { const int row = row0 + ai * 128 + m * 16; float s = 0.f;
#pragma unroll
                for (int bj = 0; bj < 2; ++bj) {
#pragma unroll
                    for (int n = 0; n < 2; ++n) { const f32x4 x = acc[ai][bj][m][n]; s += (x.x * x.x + x.y * x.y) + (x.z * x.z + x.w * x.w); }
                    *(GAS v4u*)(Y + (size_t)row * DM + u.pn * 256 + bj * 128 + ct0) = pack8(acc[ai][bj][m][0], acc[ai][bj][m][1]); }
                s = sum_rows(s);
                if (fq == 0) YSS[(size_t)row * 16 + u.pn * 4 + wc] = s; }
    }
};
struct EpiSwiglu {
    static constexpr bool PERM = true, AFTER_DRAIN = false, KSCALE = false;
    bf16* ACT; unsigned char* ACT8; int pm8;
    __device__ __forceinline__ void operator()(const f32x4 (&acc)[2][2][4][2], const Unit& u, int wr, int wc, int fr, int fq) const {
        const int row0 = u.pm * 256 + wr * 64 + fr, ct0 = wc * 32 + 8 * fq; const bool f8 = (PM8_L0 == 256 && PM8_L1 == 256) || u.pm < pm8;
#pragma unroll
        for (int ai = 0; ai < 2; ++ai)
#pragma unroll
            for (int m = 0; m < 4; ++m) { const int row = row0 + ai * 128 + m * 16; f32x4 o[2];
#pragma unroll
                for (int n = 0; n < 2; ++n) { const f32x4 g = acc[ai][0][m][n], up = acc[ai][1][m][n];
#pragma unroll
                    for (int j = 0; j < 4; ++j) o[n][j] = g[j] * up[j] * __builtin_amdgcn_rcpf(1.f + __builtin_amdgcn_exp2f(g[j])); }
                if (f8) { u32x2 w; { int t = __builtin_amdgcn_cvt_pk_fp8_f32(o[0][0], o[0][1], 0, false); t = __builtin_amdgcn_cvt_pk_fp8_f32(o[0][2], o[0][3], t, true); w.x = (unsigned)t; }
                    { int t = __builtin_amdgcn_cvt_pk_fp8_f32(o[1][0], o[1][1], 0, false); t = __builtin_amdgcn_cvt_pk_fp8_f32(o[1][2], o[1][3], t, true); w.y = (unsigned)t; }
                    *(GAS u32x2*)(ACT8 + (size_t)row * DFF + u.pn * 128 + ct0) = w; }
                else __builtin_nontemporal_store(pack8(o[0], o[1]), (GAS v4u*)(ACT + (size_t)row * DFF + u.pn * 128 + ct0)); }
    }
};

__device__ __forceinline__ int crow(int r, int hi) { return (r & 3) + 8 * (r >> 2) + 4 * hi; }
typedef short v4i16_t __attribute__((ext_vector_type(4)));
__device__ __forceinline__ float half_max(float m) { auto rr = __builtin_amdgcn_permlane32_swap(__float_as_uint(m), __float_as_uint(m), false, false); return __builtin_fmaxf(__uint_as_float(rr[0]), __uint_as_float(rr[1])); }
__device__ __forceinline__ float half_sum(float m) { auto rr = __builtin_amdgcn_permlane32_swap(__float_as_uint(m), __float_as_uint(m), false, false); return __uint_as_float(rr[0]) + __uint_as_float(rr[1]); }
namespace att {
__device__ __forceinline__ void glds16s(unsigned voff, const void* sbase, unsigned lds_dst) { unsigned keep;
    asm volatile("s_mov_b32 %0, m0\n\ts_mov_b32 m0, %2\n\ts_nop 0\n\tglobal_load_lds_dwordx4 %1, %3\n\ts_mov_b32 m0, %0" : "=&s"(keep) : "v"(voff), "s"(lds_dst), "s"(sbase) : "memory"); }
template <class T> __device__ __forceinline__ T* uniform_ptr(T* p) { const unsigned long long v = (unsigned long long)p;
    const unsigned lo = (unsigned)__builtin_amdgcn_readfirstlane((int)(unsigned)v), hi = (unsigned)__builtin_amdgcn_readfirstlane((int)(unsigned)(v >> 32)); return (T*)(((unsigned long long)hi << 32) | lo); }
typedef short s16x4 __attribute__((ext_vector_type(4)));
typedef unsigned u32x4_t __attribute__((ext_vector_type(4)));
typedef __attribute__((address_space(3))) const char* lds_cptr;
#define SBAR() __builtin_amdgcn_sched_barrier(0)
__device__ __forceinline__ float max3f(float a, float b, float c) { float r; asm("v_max3_f32 %0, %1, %2, %3" : "=v"(r) : "v"(a), "v"(b), "v"(c)); return r; }
__device__ __forceinline__ float max2f(float a, float b) { float r; asm("v_max_f32_e32 %0, %1, %2" : "=v"(r) : "v"(a), "v"(b)); return r; }
__device__ __forceinline__ float fadd_s(float a, float b) { float r; asm("v_add_f32_e32 %0, %1, %2" : "=v"(r) : "v"(a), "v"(b)); return r; }
__device__ __forceinline__ float fsub_s(float a, float b) { float r; asm("v_sub_f32_e32 %0, %1, %2" : "=v"(r) : "v"(a), "v"(b)); return r; }
#define WAIT_BAR(N) asm volatile("s_waitcnt vmcnt(" #N ") lgkmcnt(0)\n\ts_barrier" ::: "memory")
#define WB_K2V1() do { if (k2) WAIT_BAR(5); else WAIT_BAR(3); } while (0)
#define WB_K1V1() do { if (k2) WAIT_BAR(3); else WAIT_BAR(2); } while (0)
#define WB_K1V2() do { if (k2) WAIT_BAR(4); else WAIT_BAR(3); } while (0)
#define WB_K2V2() do { if (k2) WAIT_BAR(6); else WAIT_BAR(4); } while (0)
#define WB_K0V1() WAIT_BAR(1)
#define WB_0() WAIT_BAR(0)
__device__ __forceinline__ void cmask(f32x16& p0, f32x16& p1, int jb, int qrel, int hi) {
    const float NEG = -INFINITY; const int kb = 64 * jb + 4 * hi;
#pragma unroll
    for (int r = 0; r < 16; ++r) { const int kv = kb + (r & 3) + 8 * (r >> 2); if (kv > qrel) p0[r] = NEG; if (kv + 32 > qrel) p1[r] = NEG; }
}
template <int KD>
__device__ __forceinline__ void qkt(f32x16& p0, f32x16& p1, lds_cptr kb, const bf16x8* qr, const f32x16& negm) {
#pragma unroll
    for (int d0 = 0; d0 < KD; ++d0) {
        const bf16x8 b0 = *(const LAS bf16x8*)(kb + d0 * 2048);
        const bf16x8 b1 = *(const LAS bf16x8*)(kb + d0 * 2048 + 512);
        if (d0 == 0) { p0 = __builtin_amdgcn_mfma_f32_32x32x16_bf16(b0, qr[0], negm, 0, 0, 0); p1 = __builtin_amdgcn_mfma_f32_32x32x16_bf16(b1, qr[0], negm, 0, 0, 0); }
        else { p0 = __builtin_amdgcn_mfma_f32_32x32x16_bf16(b0, qr[d0], p0, 0, 0, 0); p1 = __builtin_amdgcn_mfma_f32_32x32x16_bf16(b1, qr[d0], p1, 0, 0, 0); } }
}
__device__ __forceinline__ void kload2(bf16x8* kf, lds_cptr kp, int j) { kf[2 * j] = *(const LAS bf16x8*)(kp + j * 2048); kf[2 * j + 1] = *(const LAS bf16x8*)(kp + j * 2048 + 512); }
__device__ __forceinline__ s16x4 vtr(lds_cptr p) { return __builtin_bit_cast(s16x4, __builtin_amdgcn_ds_read_tr16_b64_v4i16((LAS v4i16_t*)p)); }
__device__ __forceinline__ float rowmax(const f32x16& p0, const f32x16& p1) {
    float a = max3f(p0[0], p0[1], p1[0]), b = max3f(p0[2], p0[3], p1[1]); a = max3f(a, p1[2], p1[3]);
#pragma unroll
    for (int r = 4; r < 16; r += 4) { a = max3f(a, p0[r], p0[r + 1]); b = max3f(b, p0[r + 2], p0[r + 3]); a = max3f(a, p1[r], p1[r + 1]); b = max3f(b, p1[r + 2], p1[r + 3]); }
    const float m = max2f(a, b);
    auto rr = __builtin_amdgcn_permlane32_swap(__float_as_uint(m), __float_as_uint(m), false, false);
    return max2f(__uint_as_float(rr[0]), __uint_as_float(rr[1]));
}
__device__ __forceinline__ void pv(f32x16* o, int vb, bf16x8 pa0, bf16x8 pa1, bf16x8 pa2, bf16x8 pa3) {
#pragma unroll
    for (int d0 = 0; d0 < 2; ++d0) { s16x4 lo[4], hi[4];
#pragma unroll
        for (int ks = 0; ks < 4; ++ks) {
            asm volatile("ds_read_b64_tr_b16 %0,%1 offset:%c2" : "=&v"(lo[ks]) : "v"(vb), "i"(d0 * 4096 + ks * 1024) : "memory");
            asm volatile("ds_read_b64_tr_b16 %0,%1 offset:%c2" : "=&v"(hi[ks]) : "v"(vb), "i"(d0 * 4096 + ks * 1024 + 512) : "memory"); }
        asm volatile("s_waitcnt lgkmcnt(0)" ::: "memory"); SBAR();
#define PK(k) (bf16x8){lo[k][0], lo[k][1], lo[k][2], lo[k][3], hi[k][0], hi[k][1], hi[k][2], hi[k][3]}
        o[d0] = __builtin_amdgcn_mfma_f32_32x32x16_bf16(pa0, PK(0), o[d0], 0, 0, 0);
        o[d0] = __builtin_amdgcn_mfma_f32_32x32x16_bf16(pa1, PK(1), o[d0], 0, 0, 0);
        o[d0] = __builtin_amdgcn_mfma_f32_32x32x16_bf16(pa2, PK(2), o[d0], 0, 0, 0);
        o[d0] = __builtin_amdgcn_mfma_f32_32x32x16_bf16(pa3, PK(3), o[d0], 0, 0, 0);
#undef PK
    }
}
template <int KD> struct Lay { static constexpr int KSLOT = KD * 2048, VSLOT = 8192, LDS_K = 0, LDS_V = 3 * KSLOT, LDS_WS = LDS_V + 4 * VSLOT, LDS_TB = LDS_WS + 2048, LDS_OST = LDS_TB + 1024, LDS_END = LDS_OST + 8 * 4096; };

template <int KD, int MODE, int THRL, int KBS  , int KPITCH>
__device__ __forceinline__ void attn_unit_t(const bf16* Q, int qpitch, const bf16* __restrict__ K, const bf16* __restrict__ V, int vpitch, bf16* O,
                                            int b, int qb, LAS unsigned char* lds, const float* kmp_b, float* oss, bool pre, int nb, int nqb, const bf16* KR = nullptr  ) {
    constexpr int kpitch = KPITCH;
    typedef Lay<KD> LY; constexpr int KSLOT = LY::KSLOT, SLOTB = LY::VSLOT, LDS_K = LY::LDS_K, LDS_V = LY::LDS_V;
    static_assert(LY::LDS_END <= RING_BYTES, "attention LDS map");
    int tid = threadIdx.x; asm volatile("" : "+v"(tid));
    const int lane = tid & 63, r32 = lane & 31, hi = lane >> 5; const int wid = __builtin_amdgcn_readfirstlane(tid >> 6);
    const long rowbase = (long)b * SEQ; const int q0 = qb * 256;
    const bf16* Qw = Q + (rowbase + q0 + wid * 32) * qpitch;
    const bf16* Kh = K + (long)b * KBS, *Vh = V + rowbase * vpitch;
    const unsigned lds0 = (unsigned)(uintptr_t)lds;
    LAS float* wsf = (LAS float*)(lds + LY::LDS_WS) + wid * 64;
    const bool k2 = (wid + 8 < 2 * KD);
    const bf16* ksrc = Kh + (long)lane * kpitch + wid * 8;
    const bf16* vsrc = Vh + (long)(16 * (wid & 3) + (lane >> 2)) * vpitch + (wid >> 2) * 32 + (lane & 3) * 8;
    const unsigned kdst = lds0 + LDS_K + wid * 1024, vdst = lds0 + LDS_V + wid * 1024;
    const bf16* krh = (KD == 6) ? uniform_ptr(KR + rowbase * 32) : nullptr;
#define KO(x) (((x) >> 2) * KD)
#define DMA_K2(kbase_, krb_, t, slot) do { const unsigned kd_ = (unsigned)__builtin_amdgcn_readfirstlane(kdst + KO(slot)); glds16((kbase_) + (long)(t) * 64 * kpitch, kd_); \
        if (k2) { if constexpr (KD == 6) glds16s((unsigned)(lane * 64 + wid * 16) + (unsigned)(t) * 4096u, krb_, kd_ + 8192); else glds16((kbase_) + 64 + (long)(t) * 64 * kpitch, kd_ + 8192); } } while (0)
#define DMA_K(t, slot) DMA_K2(ksrc, krh, t, slot)
#define DMA_V(t, slot) glds16(vsrc + (long)(t) * 64 * vpitch, (unsigned)__builtin_amdgcn_readfirstlane(vdst + (slot)))
    const lds_cptr shm3 = (lds_cptr)lds;
    const lds_cptr kp0 = shm3 + LDS_K + hi * 1024 + r32 * 16;
    const lds_cptr vp0 = shm3 + LDS_V + ((lane >> 4) & 1) * 32 + (lane & 3) * 8 + (4 * hi + ((lane & 15) >> 2)) * 64;
    const int vb0 = (int)(lds0 + LDS_V) + ((lane >> 4) & 1) * 32 + (lane & 3) * 8 + (4 * hi + ((lane & 15) >> 2)) * 64;
    bf16x8 kf[2 * KD];
    const int NT = 4 * (qb + 1);
    if (!pre) { DMA_K(0, 0); DMA_V(0, 0); DMA_K(1, SLOTB); DMA_V(1, SLOTB); }
    bf16x8 qr[KD];
#pragma unroll
    for (int d0 = 0; d0 < KD; ++d0) qr[d0] = *(const GAS bf16x8*)(Qw + (long)r32 * qpitch + d0 * 16 + hi * 8);
    const int qrel = wid * 32 + r32, qpos = q0 + qrel;
    unsigned selmask = 0xffu;
    if (MODE == 1 && qb >= 4) {
        const bf16* kmf = (const bf16*)kmp_b; f32x16 ga = f32x16{};
#pragma unroll
        for (int hl = 0; hl < 2; ++hl)
#pragma unroll
            for (int d0 = 0; d0 < 4; ++d0) { const bf16x8 a = *(const GAS bf16x8*)(kmf + ((hl * 4 + d0) * 64 + lane) * 8); ga = __builtin_amdgcn_mfma_f32_32x32x16_bf16(a, qr[d0], ga, 0, 0, 0); }
        float g[8];
#pragma unroll
        for (int j = 0; j < 4; ++j) { auto rr = __builtin_amdgcn_permlane32_swap(__float_as_uint(ga[j]), __float_as_uint(ga[j]), false, false); g[j] = __uint_as_float(rr[0]); g[4 + j] = __uint_as_float(rr[1]); }
#pragma unroll
        for (int n = 0; n < 7; ++n) if (n >= qb) g[n] = -INFINITY;
        selmask = 0u;
#pragma unroll
        for (int n = 0; n < 7; ++n) { int rank = 0;
#pragma unroll
            for (int mm = 0; mm < 7; ++mm) if (mm != n) rank += (g[mm] > g[n] || (g[mm] == g[n] && mm < n)) ? 1 : 0;
            if (n < qb && rank < 3) selmask |= 1u << n; }
    }
#define SELNEG(blk_) ((MODE != 1 || (blk_) >= qb || ((selmask >> (blk_)) & 1u)) ? 0.f : -INFINITY)
    float selneg = SELNEG(0);
    float mhat = 0.f, l_reg = 0.f; f32x16 o[2]; o[0] = f32x16{}; o[1] = f32x16{}; f32x16 negm;
#pragma unroll
    for (int r = 0; r < 16; ++r) negm[r] = selneg;
    asm volatile("" : "+v"(negm));
    const LAS float* TBl = (const LAS float*)(lds + LY::LDS_TB);
#define TBIAS(P0, P1, t) do { int D0_ = qpos - 64 * (t) - 4 * hi; D0_ = D0_ < -1 ? -1 : (D0_ > 191 ? 191 : D0_); const LAS float* rb_ = TBl + (191 - D0_); \
        _Pragma("unroll") for (int r = 0; r < 16; ++r) { const int c_ = (r & 3) + 8 * (r >> 2); P0[r] += rb_[c_]; P1[r] += rb_[c_ + 32]; } } while (0)
#define CMASK(P0, P1, t) do { if (MODE == 0) { const int jb_ = (t) - (NT - 4); if (jb_ >= 0) cmask(P0, P1, jb_, qrel, hi); } else { if ((t) + 6 >= NT) TBIAS(P0, P1, t); } } while (0)
    bool resc = false;
#define START(P0, P1) do { const float rm = rowmax(P0, P1); resc = false; \
    { const float dl = __builtin_fmaxf(rm, 0.f); mhat = fadd_s(mhat, dl); \
      _Pragma("unroll") for (int r = 0; r < 16; ++r) { P0[r] = fsub_s(P0[r], dl); P1[r] = fsub_s(P1[r], dl); } \
      _Pragma("unroll") for (int r = 0; r < 16; ++r) negm[r] = selneg - mhat; asm volatile("" : "+v"(negm)); } \
    _Pragma("unroll") for (int r = 0; r < 16; ++r) P0[r] = __builtin_amdgcn_exp2f(P0[r]); } while (0)
#define RESC() do { if (resc) { asm volatile("s_waitcnt lgkmcnt(0)" ::: "memory"); \
      _Pragma("unroll") for (int d_ = 0; d_ < 2; ++d_) _Pragma("unroll") for (int r = 0; r < 16; ++r) o[d_][r] *= wsf[crow(r, hi)]; } } while (0)
#define NEXTBLK(t) do { if (MODE == 1 && (((t) + 1) & 3) == 0) { selneg = SELNEG(((t) + 1) >> 2); _Pragma("unroll") for (int r = 0; r < 16; ++r) negm[r] = selneg - mhat; asm volatile("" : "+v"(negm)); } } while (0)
    f32x16 pA0, pA1, pB0, pB1;
    int sl_cur = 0, sl_next = SLOTB;
    int vs_prev = 0, vs_cur = 0, vs_next = SLOTB, vs_nn = 2 * SLOTB;
#define ROT() do { sl_cur = sl_next; sl_next = (sl_next == 2 * SLOTB) ? 0 : sl_next + SLOTB; vs_prev = vs_cur; vs_cur = vs_next; vs_next = vs_nn; vs_nn = (vs_nn == 3 * SLOTB) ? 0 : vs_nn + SLOTB; } while (0)
    if (!pre) DMA_K(2, 2 * SLOTB);
    WB_K2V2();
    qkt<KD>(pA0, pA1, kp0, qr, negm); asm volatile("s_nop 15\n\ts_nop 7" : "+v"(pA0), "+v"(pA1)); CMASK(pA0, pA1, 0);
    START(pA0, pA1);
#pragma unroll
    for (int r = 0; r < 16; ++r) pA1[r] = __builtin_amdgcn_exp2f(pA1[r]);
    NEXTBLK(0);
    WB_0();
    DMA_K(3, 0); DMA_V(2, 2 * SLOTB);
    ROT();
#pragma unroll
    for (int j = 0; j < KD; ++j) kload2(kf, kp0 + KO(sl_cur), j);
    WB_K1V1();
    s16x4 vlo[8], vhi[8]; u32x4_t pw0, pw1, pw2, pw3;
#define PKW(P, B) pk2(P[B], P[B + 1])
#define PAF(k) __builtin_bit_cast(bf16x8, pw##k)
#define VFR(i) (bf16x8){vlo[i][0], vlo[i][1], vlo[i][2], vlo[i][3], vhi[i][0], vhi[i][1], vhi[i][2], vhi[i][3]}
#define PIN(x) asm volatile("" : "+v"(x))
#define MX3(a, b, c) __builtin_fmaxf(__builtin_fmaxf((a), (b)), (c))
#define MF(a, b, c) __builtin_amdgcn_mfma_f32_32x32x16_bf16(a, b, c, 0, 0, 0)
#define GAPA(MFX, A0, A1, A2, A3, W0, W1, PW) do { MFX; sacc += A0; sacc += A1; sacc += A2; sacc += A3; PIN(sacc); W0; W1; PIN(PW); SBAR(); } while (0)
#define EX(v) __builtin_amdgcn_exp2f(v)
#define GAPB(MFX, X, B) do { MFX; X[B] = EX(X[B]); X[B + 1] = EX(X[B + 1]); X[B + 2] = EX(X[B + 2]); X[B + 3] = EX(X[B + 3]); PIN(X); SBAR(); } while (0)
#define VRD(i) do { vlo[i] = vtr(vp_ + (((i) >> 2) * 4096 + ((i) & 3) * 1024)); vhi[i] = vtr(vp_ + (((i) >> 2) * 4096 + ((i) & 3) * 1024 + 512)); } while (0)
#define KRD(G, j) do { if (G) { kload2(kf, kp0 + KO(sl_next), j); SBAR(); } } while (0)
#define STEP(C0, C1, P0, P1, t, GK, GV, GL) do { SBAR(); \
    const lds_cptr vp_ = vp0 + vs_prev; \
    VRD(0); SBAR(); float sacc = (P0[0] + P0[1]); \
    GAPA(C0 = MF(kf[0], qr[0], negm), P0[2], P0[3], P0[4], P0[5],     pw0[0] = PKW(P0, 0), pw0[1] = PKW(P0, 2), pw0); \
    VRD(4); SBAR(); GAPA(C1 = MF(kf[1], qr[0], negm), P0[6], P0[7], P0[8], P0[9],     pw0[2] = PKW(P0, 4), pw0[3] = PKW(P0, 6), pw0); \
    VRD(1); SBAR(); GAPA(C0 = MF(kf[2], qr[1], C0),   P0[10], P0[11], P0[12], P0[13], pw1[0] = PKW(P0, 8), pw1[1] = PKW(P0, 10), pw1); \
    VRD(5); SBAR(); GAPA(C1 = MF(kf[3], qr[1], C1),   P0[14], P0[15], P1[0], P1[1],   pw1[2] = PKW(P0, 12), pw1[3] = PKW(P0, 14), pw1); \
    VRD(2); SBAR(); GAPA(C0 = MF(kf[4], qr[2], C0),   P1[2], P1[3], P1[4], P1[5],     pw2[0] = PKW(P1, 0), pw2[1] = PKW(P1, 2), pw2); \
    VRD(6); SBAR(); GAPA(C1 = MF(kf[5], qr[2], C1),   P1[6], P1[7], P1[8], P1[9],     pw2[2] = PKW(P1, 4), pw2[3] = PKW(P1, 6), pw2); \
    VRD(3); SBAR(); GAPA(C0 = MF(kf[6], qr[3], C0),   P1[10], P1[11], P1[12], P1[13], pw3[0] = PKW(P1, 8), pw3[1] = PKW(P1, 10), pw3); \
    VRD(7); SBAR(); GAPA(C1 = MF(kf[7], qr[3], C1),   P1[14], P1[15], 0.f, 0.f,       pw3[2] = PKW(P1, 12), pw3[3] = PKW(P1, 14), pw3); \
    if constexpr (KD > 4) { C0 = MF(kf[8], qr[4], C0); SBAR(); C1 = MF(kf[9], qr[4], C1); SBAR(); } \
    if constexpr (KD > 5) { C0 = MF(kf[2 * KD - 2], qr[KD - 1], C0); SBAR(); C1 = MF(kf[2 * KD - 1], qr[KD - 1], C1); SBAR(); } \
    l_reg += sacc; \
    if (GK) { DMA_K((t) + 3, sl_cur); } if (GV) { DMA_V((t) + 2, vs_nn); } \
    CMASK(C0, C1, t); \
    { float a = MX3(C0[0], C0[1], C1[0]), b_ = MX3(C0[2], C0[3], C1[1]); a = MX3(a, C1[2], C1[3]); \
      _Pragma("unroll") for (int r = 4; r < 16; r += 4) { a = MX3(a, C0[r], C0[r + 1]); b_ = MX3(b_, C0[r + 2], C0[r + 3]); a = MX3(a, C1[r], C1[r + 1]); b_ = MX3(b_, C1[r + 2], C1[r + 3]); } \
      float rm = __builtin_fmaxf(a, b_); { auto rr = __builtin_amdgcn_permlane32_swap(__float_as_uint(rm), __float_as_uint(rm), false, false); rm = __builtin_fmaxf(__uint_as_float(rr[0]), __uint_as_float(rr[1])); } \
      resc = false; \
      if (__builtin_expect(__any(rm > (float)THRL), 0)) { const float dl = __builtin_fmaxf(rm, 0.f); mhat += dl; \
        _Pragma("unroll") for (int r = 0; r < 16; ++r) { C0[r] -= dl; C1[r] -= dl; } \
        _Pragma("unroll") for (int r = 0; r < 16; ++r) negm[r] = selneg - mhat; asm volatile("" : "+v"(negm)); \
        const float f = __builtin_amdgcn_exp2f(-dl); l_reg *= f; if (hi == 0) wsf[r32] = f; resc = true; } } \
    SBAR(); \
    GAPB(o[0] = MF(PAF(0), VFR(0), o[0]), C0, 0); \
    GAPB(o[1] = MF(PAF(0), VFR(4), o[1]), C0, 4); \
    KRD(GL, 0); GAPB(o[0] = MF(PAF(1), VFR(1), o[0]), C0, 8); \
    KRD(GL, 1); GAPB(o[1] = MF(PAF(1), VFR(5), o[1]), C0, 12); \
    KRD(GL, 2); GAPB(o[0] = MF(PAF(2), VFR(2), o[0]), C1, 0); \
    KRD(GL, 3); GAPB(o[1] = MF(PAF(2), VFR(6), o[1]), C1, 4); \
    if constexpr (KD > 4) KRD(GL, 4); GAPB(o[0] = MF(PAF(3), VFR(3), o[0]), C1, 8); \
    if constexpr (KD > 5) KRD(GL, 5); GAPB(o[1] = MF(PAF(3), VFR(7), o[1]), C1, 12); \
    NEXTBLK(t); \
    } while (0)
    int t = 1;
#define CMASK_FULL(P0, P1, t) do { if (MODE == 0) { const int jb_ = (t) - (NT - 4); if (jb_ >= 0) cmask(P0, P1, jb_, qrel, hi); } else { if ((t) + 6 >= NT) TBIAS(P0, P1, t); } } while (0)
#undef CMASK
#define CMASK(P0, P1, t) do { } while (0)
    for (; t + 7 < NT; t += 2) {
        STEP(pB0, pB1, pA0, pA1, t, true, true, true);     WB_K1V2(); RESC(); ROT();
        STEP(pA0, pA1, pB0, pB1, t + 1, true, true, true); WB_K1V2(); RESC(); ROT();
    }
#undef CMASK
#define CMASK(P0, P1, t) CMASK_FULL(P0, P1, t)
#define ENDW(tt) do { if ((tt) + 3 < NT) { WB_K1V2(); } else if ((tt) + 2 < NT) { WAIT_BAR(2); } else { WB_0(); } } while (0)
    for (; t + 1 < NT; t += 2) {
        STEP(pB0, pB1, pA0, pA1, t, (t + 3 < NT), (t + 2 < NT), (t + 1 < NT));         ENDW(t);     RESC(); ROT();
        STEP(pA0, pA1, pB0, pB1, t + 1, (t + 4 < NT), (t + 3 < NT), (t + 2 < NT));     ENDW(t + 1); RESC(); ROT();
    }
    if (nqb >= 0) {
        const long nd_ = (long)(nb - b) * SEQ; const bf16* ksn_ = ksrc + (long)(nb - b) * KBS; const bf16* vsn_ = vsrc + nd_ * vpitch; const bf16* krn_ = (KD == 6) ? uniform_ptr(KR + (long)nb * SEQ * 32) : nullptr; (void)krn_;
#define DMA_KN(t, slot) DMA_K2(ksn_, krn_, t, slot)
#define DMA_VN(t, slot) glds16(vsn_ + (long)(t) * 64 * vpitch, (unsigned)__builtin_amdgcn_readfirstlane(vdst + (slot)))
        DMA_KN(0, 0); DMA_VN(0, 0); DMA_KN(1, SLOTB); DMA_VN(1, SLOTB); DMA_KN(2, 2 * SLOTB);
#undef DMA_KN
#undef DMA_VN
    }
    STEP(pB0, pB1, pA0, pA1, NT - 1, false, false, false); RESC();
    { float sacc = pB0[0] + pB0[1];
#pragma unroll
      for (int r = 2; r < 16; ++r) sacc += pB0[r];
#pragma unroll
      for (int r = 0; r < 16; ++r) sacc += pB1[r];
      l_reg += sacc;
      pw0 = (u32x4_t){PKW(pB0, 0), PKW(pB0, 2), PKW(pB0, 4), PKW(pB0, 6)}; pw1 = (u32x4_t){PKW(pB0, 8), PKW(pB0, 10), PKW(pB0, 12), PKW(pB0, 14)};
      pw2 = (u32x4_t){PKW(pB1, 0), PKW(pB1, 2), PKW(pB1, 4), PKW(pB1, 6)}; pw3 = (u32x4_t){PKW(pB1, 8), PKW(pB1, 10), PKW(pB1, 12), PKW(pB1, 14)};
      SBAR(); pv(o, vb0 + vs_cur, PAF(0), PAF(1), PAF(2), PAF(3)); }
    l_reg = half_sum(l_reg);
    if (hi == 0) wsf[32 + r32] = l_reg; asm volatile("s_waitcnt lgkmcnt(0)" ::: "memory");
    float rli[16];
#pragma unroll
    for (int r = 0; r < 16; ++r) rli[r] = __builtin_amdgcn_rcpf(wsf[32 + crow(r, hi)]);
    bf16* Ow = O + (rowbase + q0 + wid * 32) * DM;
    { LAS unsigned short* stg = (LAS unsigned short*)(lds + LY::LDS_OST) + wid * 2048;
#pragma unroll
      for (int r = 0; r < 16; ++r) { const int orow = crow(r, hi);
#pragma unroll
          for (int d0 = 0; d0 < 2; ++d0) stg[orow * 64 + d0 * 32 + r32] = f2bf1(o[d0][r] * rli[r]); }
      asm volatile("s_waitcnt lgkmcnt(0)" ::: "memory");
#pragma unroll
      for (int i = 0; i < 4; ++i) { const int row = i * 8 + (lane >> 3), ch = lane & 7; const v4u v = *(const LAS v4u*)(stg + row * 64 + ch * 8); *(GAS v4u*)(Ow + (long)row * DM + ch * 8) = v;
          float ss; { const float a0 = __uint_as_float(v.x << 16), a1 = __uint_as_float(v.x & 0xffff0000u), a2 = __uint_as_float(v.y << 16), a3 = __uint_as_float(v.y & 0xffff0000u);
              const float a4 = __uint_as_float(v.z << 16), a5 = __uint_as_float(v.z & 0xffff0000u), a6 = __uint_as_float(v.w << 16), a7 = __uint_as_float(v.w & 0xffff0000u);
              ss = ((a0 * a0 + a1 * a1) + (a2 * a2 + a3 * a3)) + ((a4 * a4 + a5 * a5) + (a6 * a6 + a7 * a7)); }
          ss = sum8(ss);
          if (ch == 0) oss[(rowbase + q0 + 32 * wid + row) * 16] = ss; } }
    if (nqb >= 0) asm volatile("s_waitcnt lgkmcnt(0)\n\ts_barrier" ::: "memory");
    else asm volatile("s_waitcnt vmcnt(0) lgkmcnt(0)\n\ts_barrier" ::: "memory");
#undef KO
#undef DMA_K
#undef DMA_K2
#undef DMA_V
#undef SELNEG
#undef TBIAS
#undef CMASK
#undef CMASK_FULL
#undef START
#undef RESC
#undef NEXTBLK
#undef ROT
#undef PKW
#undef PAF
#undef VFR
#undef PIN
#undef MX3
#undef MF
#undef GAPA
#undef EX
#undef GAPB
#undef VRD
#undef KRD
#undef STEP
#undef ENDW
}
#undef SBAR
#undef WAIT_BAR
}
#define ATTN_TB att::Lay<4>::LDS_TB
struct RotOrder {
    pg8::StaticOrder S;
    __device__ void init(int M, int N, int G_, int c_) { S.init(M, N, G_, c_); }
    __device__ bool next(int i, pg8::Unit& u) const { if (!S.next(i, u)) return false; u.pn = (u.pn + (i >> 1)) & 7; return true; }
    __device__ __forceinline__ void a_ready(const pg8::Unit&) const {}
    __device__ __forceinline__ void done(const pg8::Unit&) const {}
};
struct Args { const float* in[19]; float* out; unsigned char* ws; int ph_lo, ph_hi, li, pad; };
constexpr int NPH_L = 10, NPH = 2 + NPH_L * NLAYER;

__global__ void __launch_bounds__(NTHR, 2) mk_fwd(Args args) {
    extern __shared__ __attribute__((aligned(16))) unsigned char lds_raw[];
    LAS unsigned char* lds = (LAS unsigned char*)lds_raw;
    volatile LAS unsigned* MISC = (volatile LAS unsigned*)(lds + MISC_OFF);
    const int tid0 = threadIdx.x;
    const int G = gridDim.x, bx = blockIdx.x, NGW = G * NWAVES;
    unsigned* ctl = (unsigned*)(args.ws + WS_CTL);
    for (int u = tid0; u < (LDS_BYTES - RING_BYTES) / 4; u += NTHR) ((LAS unsigned*)(lds + RING_BYTES))[u] = 0u;
    __syncthreads();
    XcdBarrier bar; bar.bar = ctl + CW_BAR + args.li * XCD_BAR_WORDS; bar.x = 0; bar.st = nullptr;
    if (MK_FUSED) bar = xcd_barrier_post(ctl + CW_BAR + args.li * XCD_BAR_WORDS, MISC + 8);
    const int lo = args.ph_lo, hi = args.ph_hi; (void)lo; (void)hi;
#ifndef PHMASK
#define PHMASK 0xffffffffu
#endif
#define IN(k) (lo <= (k) && (k) < hi)
#define PHON(i) ((PHMASK >> (i)) & 1u)
#define SEAM(k) do { if (IN(k) && IN((k) + 1)) xcd_barrier(bar); } while (0)

    typedef const Args __attribute__((address_space(4)))* ArgsP;
    unsigned char* ws0 = args.ws; ArgsP ap0 = (ArgsP)__builtin_amdgcn_kernarg_segment_ptr();
#define PHASE_BEGIN() unsigned char* wsp = ws0; ArgsP AP = ap0; int tid = tid0; asm volatile("" : "+s"(wsp), "+s"(AP), "+v"(tid)); \
    const int lane = tid & 63, wave = __builtin_amdgcn_readfirstlane(tid >> 6), gw = bx * NWAVES + wave; (void)lane; (void)gw
#define WSF(off) ((float*)ws_at(wsp, (off)))
#define WSB(off) ((bf16*)ws_at(wsp, (off)))
    if (PHON(0) && IN(0)) {
        PHASE_BEGIN(); float* CMOD = WSF(WS_CMOD); f32x2* ROPE = (f32x2*)ws_at(wsp, WS_ROPE); float* TB = WSF(WS_TB);
        LAS float* scr = (LAS float*)(lds + wave * 16384);
        for (int l = 0; l < NLAYER; ++l) {
            unsigned char* wl = ws_at(wsp, WS_W + l * W_LAYER);
#define PREP_MAT(W_, Ksrc_, Nsrc_, WT_, Kdst_, Ndst_, map_, ks_) do { const int nnb_ = (Ndst_) / 32, nit_ = ((Kdst_) / 64) * nnb_; \
                for (int it = gw; it < nit_; it += NGW) prep_item((W_), (Ksrc_), (Nsrc_), (WT_), (Kdst_), (map_), (ks_), scr, it / nnb_, it % nnb_, lane); } while (0)
            PREP_MAT(AP->in[7] + (size_t)l * DM * IN_W, DM, IN_W, (bf16*)ws_at(wl, WO_IN), DM, 2048, 0, (const float*)nullptr);
            PREP_MAT(AP->in[10] + (size_t)l * 256 * 768, 256, 768, (bf16*)ws_at(wl, WO_UQ), 256, 768, 1, AP->in[9] + l * 256);
            PREP_MAT(AP->in[12] + (size_t)l * 128 * 1024, 128, 1024, (bf16*)ws_at(wl, WO_UKV), 128, 1024, 1, AP->in[11] + l * 128);
            PREP_MAT(AP->in[14] + (size_t)l * DM * DM, DM, DM, (bf16*)ws_at(wl, WO_OUT), DM, DM, 1, AP->in[13] + l * DM);
            PREP_MAT(AP->in[17] + (size_t)l * DM * 2 * DFF, DM, 2 * DFF, (bf16*)ws_at(wl, WO_GU), DM, 2 * DFF, 2, (const float*)nullptr);
            if constexpr (PM8_L0 < 256 || PM8_L1 < 256) { PREP_MAT(AP->in[18] + (size_t)l * DFF * DM, DFF, DM, (bf16*)ws_at(wl, WO_DN), DFF, DM, 3, (const float*)nullptr); }
            for (int it = gw; it < (DFF / 64) * (DM / 32); it += NGW) prep_item8(AP->in[18] + (size_t)l * DFF * DM, DM, ws_at(wsp, WS_DN8 + l * DN8_LAYER), DFF, WDN_SC, scr, it / (DM / 32), it % (DM / 32), lane);
#undef PREP_MAT
        }
        __syncthreads();
        for (int i = bx * NTHR + tid; i < SEQ * 16; i += G * NTHR) { const int s = i >> 4, k = i & 15; float c, sn; sincos_acc((float)s * rope_invfreq(k), c, sn); ROPE[i] = (f32x2){c, sn}; }
        for (int i = bx * NTHR + tid; i < 4 * 132; i += G * NTHR) { const int h = i / 132, d = i % 132; const float* t5 = AP->in[2];
            WSF(WS_TB)[i] = (d < 128) ? (t5[t5_bucket_dev(d) * 4 + h] - t5[31 * 4 + h]) * LOG2E : 0.f; }
        for (int task = bx; task < NLAYER * 96; task += G) {
            const int l = task / 96, jc = task % 96;
            __syncthreads();
            LAS float* ca = (LAS float*)(lds + wave * 16384);
            for (int i = lane; i < 128 * 32; i += 64) { const int bb = i >> 7, kk = i & 127; const float cv = AP->in[1][bb * DM + wave * 128 + kk]; ca[kk * 32 + bb] = cv / (1.f + __expf(-cv)); }
            LDS_WAIT(); asm volatile("" ::: "memory");
            float accm[32];
#pragma unroll
            for (int i = 0; i < 32; ++i) accm[i] = 0.f;
            const float* wa = AP->in[3] + ((size_t)l * DM + wave * 128) * 6144 + jc * 64 + lane;
#pragma unroll 1
            for (int kk0 = 0; kk0 < 128; kk0 += 16) { float wq[16];
#pragma unroll
                for (int u = 0; u < 16; ++u) wq[u] = wa[(size_t)(kk0 + u) * 6144];
#pragma unroll
                for (int u = 0; u < 16; ++u) { const float w = wq[u];
#pragma unroll
                    for (int q4 = 0; q4 < 8; ++q4) { const f32x4 cv = *(const LAS f32x4*)(ca + (kk0 + u) * 32 + 4 * q4);
                        accm[4 * q4 + 0] += w * cv.x; accm[4 * q4 + 1] += w * cv.y; accm[4 * q4 + 2] += w * cv.z; accm[4 * q4 + 3] += w * cv.w; } } }
            __syncthreads();
            LAS float* red = (LAS float*)lds;
#pragma unroll
            for (int i = 0; i < 32; ++i) red[(wave * 32 + i) * 64 + lane] = accm[i];
            __syncthreads();
            for (int o = tid; o < 2048; o += NTHR) { const int bb = o >> 6, col = o & 63; float s = 0.f;
#pragma unroll
                for (int w = 0; w < 8; ++w) s += red[(w * 32 + bb) * 64 + col];
                const int j = jc * 64 + col, chunk = j >> 10, cc = j & 1023; const float mod = s + AP->in[4][l * 6144 + j];
                float r = mod;
                if (chunk == 1) r = AP->in[5][l * DM + cc] * (1.f + mod); else if (chunk == 2) r = mod * AP->in[6][l * DM + cc];
                else if (chunk == 4) r = AP->in[15][l * DM + cc] * (1.f + mod); else if (chunk == 5) r = mod * AP->in[16][l * DM + cc];
                CMOD[(((size_t)l * NB + bb) * 6 + chunk) * DM + cc] = r; }
        }
        __syncthreads();
    }
    SEAM(0);
    if (PHON(1) && IN(1)) { PHASE_BEGIN(); prenorm_rows(AP->in[0], WSF(WS_CMOD), 1, 0, WSB(WS_H), gw, NGW, lane); }
    SEAM(1);

    for (int l = 0; l < NLAYER; ++l) {
        const int pb = 2 + l * NPH_L;
        if (PHON(2) && IN(pb + 0)) { PHASE_BEGIN(); unsigned char* wl = ws_at(wsp, WS_W + l * W_LAYER); const float* cmod_l = WSF(WS_CMOD) + (size_t)l * NB * 6 * DM; (void)wl; (void)cmod_l;
            pg8::Gemm g{WSB(WS_H), (const bf16*)ws_at(wl, WO_IN), MTOK, 2048, DM}; RotOrder S; S.init(MTOK, 2048, G, bx);
            EpiInproj E{wsp, AP->in[8] + l * 4};
            pg8::gemm_phase<EpiInproj, RotOrder, true, true>(lds, g, S, E);
        }
        SEAM(pb + 0);
        if (PHON(3) && IN(pb + 1)) { PHASE_BEGIN(); unsigned char* wl = ws_at(wsp, WS_W + l * W_LAYER); const float* cmod_l = WSF(WS_CMOD) + (size_t)l * NB * 6 * DM; (void)wl; (void)cmod_l;
#ifndef P1_SEL
#define P1_SEL 7
#endif
            if (P1_SEL & 1) { fox_scan(WSF(WS_LOGF), WSF(WS_PSUM), WSB(WS_QF), WSB(WS_KF), gw, NGW, lane, (LAS float*)(lds + RING_BYTES + 9216 + wave * 256)  ); build_kmf(WSF(WS_KMP), WSB(WS_KMF), NGW - 1 - gw, NGW, lane); }
        }
        SEAM(pb + 1);
        if (PHON(4) && IN(pb + 2)) { PHASE_BEGIN(); unsigned char* wl = ws_at(wsp, WS_W + l * W_LAYER); const float* cmod_l = WSF(WS_CMOD) + (size_t)l * NB * 6 * DM; (void)wl; (void)cmod_l;
            const int vcu = (G % 8 == 0) ? (bx % 8) * (G / 8) + bx / 8 : bx;
#define UNIT_LIST(NP_, HEADS_, CALL_) do { const int npair_ = (vcu < (NP_)) ? ((NP_) - vcu + G - 1) / G : 0; \
                for (int u_ = 0; u_ < 2 * npair_; ++u_) { const int p = vcu + G * (u_ >> 1), bh = p >> 2, s = p & 3, b = bh / (HEADS_), h = bh % (HEADS_); const int qb = (u_ & 1) ? 7 - s : s; \
                    int nb = 0, nqb = -1; if (u_ + 1 < 2 * npair_) { const int p2 = vcu + G * ((u_ + 1) >> 1), bh2 = p2 >> 2, s2 = p2 & 3; if (bh2 % (HEADS_) == h) { nb = bh2 / (HEADS_); nqb = ((u_ + 1) & 1) ? 7 - s2 : s2; } } \
                    bool pre = false; if (u_ > 0) { const int p0 = vcu + G * ((u_ - 1) >> 1); pre = ((p0 >> 2) % (HEADS_)) == h; } \
                    CALL_; } } while (0)
            const bool gemm_first = true;
#pragma unroll 1
            for (int step = 0; step < 2; ++step) {
                if ((step == 0) == gemm_first) {
                if (P1_SEL & 2) { pg8::Gemm g{WSB(WS_CQ), (const bf16*)ws_at(wl, WO_UQ), MTOK, 768, 256}; pg8::StaticOrder S; S.init(MTOK, 768, G, bx);
                  EpiQup E{WSB(WS_QC), WSF(WS_CQSS), (const f32x2*)ws_at(wsp, WS_ROPE)}; pg8::gemm_phase<EpiQup, pg8::StaticOrder, true, true>(lds, g, S, E); }
                if (P1_SEL & 4) { pg8::Gemm g{WSB(WS_T7), (const bf16*)ws_at(wl, WO_UKV), MTOK, 1024, 128};   pg8::StaticOrder S; S.init(MTOK, 1024, G, bx);
                  EpiKVup E{WSB(WS_KC), WSB(WS_VC), WSF(WS_CKVSS)}; pg8::gemm_phase<EpiKVup, pg8::StaticOrder, true, true, false, true>(lds, g, S, E); }
                } else {
            UNIT_LIST(NB * 4 * 4, 4, (att::attn_unit_t<5, 0, 8, 4 * SEQ * 80, 80>(WSB(WS_QF) + h * 80, 320, WSB(WS_KF) + h * (SEQ * 80), WSB(WS_VF) + h * 64, 256, WSB(WS_O) + h * 64, b, qb, lds, nullptr, WSF(WS_OSS) + h, pre, nb, nqb)));
            int tb_h = -1;
            UNIT_LIST(NB * 4 * 4, 4, ({ if (h != tb_h) { __syncthreads(); if (tid < 256) { const int d = 191 - tid; ((LAS float*)(lds + ATTN_TB))[tid] = d < 0 ? -INFINITY : (d < 128 ? WSF(WS_TB)[h * 132 + d] : 0.f); } __syncthreads(); tb_h = h; }
                att::attn_unit_t<4, 1, 8, SEQ * 256, 256>(WSB(WS_QM) + h * 64, 256, WSB(WS_KM) + h * 64, WSB(WS_VM) + h * 64, 256, WSB(WS_O) + 256 + h * 64, b, qb, lds, (const float*)(WSB(WS_KMF) + (size_t)(b * 4 + h) * 4096), WSF(WS_OSS) + 4 + h, pre, nb, nqb); }));
                }
            }
#undef UNIT_LIST
        }
        SEAM(pb + 2);
        if (PHON(5) && IN(pb + 3)) { PHASE_BEGIN(); unsigned char* wl = ws_at(wsp, WS_W + l * W_LAYER); const float* cmod_l = WSF(WS_CMOD) + (size_t)l * NB * 6 * DM; (void)wl; (void)cmod_l;
            const int vcu = (G % 8 == 0) ? (bx % 8) * (G / 8) + bx / 8 : bx;
#define UNIT_LIST(NP_, HEADS_, CALL_) do { const int npair_ = (vcu < (NP_)) ? ((NP_) - vcu + G - 1) / G : 0; \
                for (int u_ = 0; u_ < 2 * npair_; ++u_) { const int p = vcu + G * (u_ >> 1), bh = p >> 2, s = p & 3, b = bh / (HEADS_), h = bh % (HEADS_); const int qb = (u_ & 1) ? 7 - s : s; \
                    int nb = 0, nqb = -1; if (u_ + 1 < 2 * npair_) { const int p2 = vcu + G * ((u_ + 1) >> 1), bh2 = p2 >> 2, s2 = p2 & 3; if (bh2 % (HEADS_) == h) { nb = bh2 / (HEADS_); nqb = ((u_ + 1) & 1) ? 7 - s2 : s2; } } \
                    bool pre = false; if (u_ > 0) { const int p0 = vcu + G * ((u_ - 1) >> 1); pre = ((p0 >> 2) % (HEADS_)) == h; } \
                    CALL_; } } while (0)
            UNIT_LIST(NB * 8 * 4, 8, (att::attn_unit_t<6, 0, 8, 8 * SEQ * 64, 64>(WSB(WS_QC) + h * 96, 768, WSB(WS_KC) + h * (SEQ * 64), WSB(WS_VC) + h * 64, 512, WSB(WS_O) + 512 + h * 64, b, qb, lds, nullptr, WSF(WS_OSS) + 8 + h, pre, nb, nqb, WSB(WS_KR))));
#undef UNIT_LIST
        }
        SEAM(pb + 3);
        if (PHON(6) && IN(pb + 4)) { PHASE_BEGIN();
            for (int m = bx * NTHR + tid; m < MTOK; m += G * NTHR) { const GAS f32x4* sp = (const GAS f32x4*)(WSF(WS_OSS) + (size_t)m * 16); const f32x4 a = sp[0], c = sp[1], d = sp[2], e = sp[3];
                const float r0 = fast_rsqrt(((a.x + a.y) + (a.z + a.w)) * (1.f / 256.f) + RMS_EPS), r1 = fast_rsqrt(((c.x + c.y) + (c.z + c.w)) * (1.f / 256.f) + RMS_EPS);
                const float r2 = fast_rsqrt((((d.x + d.y) + (d.z + d.w)) + ((e.x + e.y) + (e.z + e.w))) * (1.f / 512.f) + RMS_EPS);
                *(GAS f32x4*)(WSF(WS_F) + (size_t)m * 4) = (f32x4){r0 / r1, r1 / r2, r2, 0.f}; } }
        SEAM(pb + 4);
        if (PHON(7) && IN(pb + 5)) { PHASE_BEGIN(); unsigned char* wl = ws_at(wsp, WS_W + l * W_LAYER); const float* cmod_l = WSF(WS_CMOD) + (size_t)l * NB * 6 * DM; (void)wl; (void)cmod_l;
            pg8::Gemm g{WSB(WS_O), (const bf16*)ws_at(wl, WO_OUT), MTOK, DM, DM}; pg8::StaticOrder S; S.init(MTOK, DM, G, bx);
            EpiYks E{WSB(WS_Y), WSF(WS_YSS), WSF(WS_F), (LAS float*)(lds + RING_BYTES + 1024)}; pg8::gemm_phase<EpiYks, pg8::StaticOrder, true, true>(lds, g, S, E);
        }
        SEAM(pb + 5);
        if (PHON(8) && IN(pb + 6)) { PHASE_BEGIN(); unsigned char* wl = ws_at(wsp, WS_W + l * W_LAYER); const float* cmod_l = WSF(WS_CMOD) + (size_t)l * NB * 6 * DM; (void)wl; (void)cmod_l;
            if (l == 0) post_rows<false, true>(AP->in[0], WSB(WS_XB), WSB(WS_Y), WSF(WS_YSS), RMS_EPS, cmod_l, 2, true, cmod_l, 4, 3, WSB(WS_H), gw, NGW, lane);
            else post_rows<true, true>(WSB(WS_XB), WSB(WS_XB), WSB(WS_Y), WSF(WS_YSS), RMS_EPS, cmod_l, 2, true, cmod_l, 4, 3, WSB(WS_H), gw, NGW, lane); }
        SEAM(pb + 6);
        if (PHON(9) && IN(pb + 7)) { PHASE_BEGIN(); unsigned char* wl = ws_at(wsp, WS_W + l * W_LAYER); const float* cmod_l = WSF(WS_CMOD) + (size_t)l * NB * 6 * DM; (void)wl; (void)cmod_l;
            pg8::Gemm g{WSB(WS_H), (const bf16*)ws_at(wl, WO_GU), MTOK, 2 * DFF, DM}; pg8::StaticOrder S; S.init(MTOK, 2 * DFF, G, bx);
            EpiSwiglu E{WSB(WS_ACT), ws_at(wsp, WS_ACT8), l == 0 ? PM8_L0 : PM8_L1}; pg8::gemm_phase<EpiSwiglu, pg8::StaticOrder, true, true>(lds, g, S, E);
        }
        SEAM(pb + 7);
        if (PHON(10) && IN(pb + 8)) { PHASE_BEGIN(); unsigned char* wl = ws_at(wsp, WS_W + l * W_LAYER); const float* cmod_l = WSF(WS_CMOD) + (size_t)l * NB * 6 * DM; (void)wl; (void)cmod_l;
            const int m8 = (l == 0 ? PM8_L0 : PM8_L1) * 256;
            if (m8 > 0) { pg8::Gemm g{(const bf16*)ws_at(wsp, WS_ACT8), (const bf16*)ws_at(wsp, WS_DN8 + l * DN8_LAYER), m8, DM, DFF / 2}; pg8::StaticOrder S; S.init(m8, DM, G, bx);
                EpiY E{WSB(WS_Y), WSF(WS_YSS)}; pg8::gemm_phase<EpiY, pg8::StaticOrder, true, true, true>(lds, g, S, E); }
            if (m8 < MTOK) { pg8::Gemm g{WSB(WS_ACT) + (size_t)m8 * DFF, (const bf16*)ws_at(wl, WO_DN), MTOK - m8, DM, DFF}; pg8::StaticOrder S; S.init(MTOK - m8, DM, G, bx);
                EpiY E{WSB(WS_Y) + (size_t)m8 * DM, WSF(WS_YSS) + (size_t)m8 * 16}; pg8::gemm_phase<EpiY, pg8::StaticOrder, true, true>(lds, g, S, E); }
        }
        SEAM(pb + 8);
        if (PHON(11) && IN(pb + 9)) { PHASE_BEGIN(); unsigned char* wl = ws_at(wsp, WS_W + l * W_LAYER); const float* cmod_l = WSF(WS_CMOD) + (size_t)l * NB * 6 * DM; (void)wl; (void)cmod_l;
            if (l + 1 < NLAYER) post_rows<true, true>(WSB(WS_XB), WSB(WS_XB), WSB(WS_Y), WSF(WS_YSS), RMS_EPS / (DN_OSC * DN_OSC), cmod_l, 5, true, cmod_l + (size_t)NB * 6 * DM, 1, 0, WSB(WS_H), gw, NGW, lane);
            else post_rows<true, false>(WSB(WS_XB), AP->out, WSB(WS_Y), WSF(WS_YSS), RMS_EPS / (DN_OSC * DN_OSC), cmod_l, 5, false, cmod_l, 1, 0, WSB(WS_H), gw, NGW, lane); }
        SEAM(pb + 9);
    }
#undef IN
#undef SEAM
}

extern "C" void kernel_launch(void* const* d_in, const int* in_sizes, int n_in, void* d_out, int out_size, void* d_ws, size_t ws_size, hipStream_t stream) {
    static int grid = 0;
    if (grid == 0) {
        if (n_in != 19 || in_sizes[0] != MTOK * DM || out_size != MTOK * DM || ws_size < WS_END) { fprintf(stderr, "kernel_launch: unexpected shapes / workspace (n_in %d, ws %zu); nothing launched\n", n_in, ws_size); grid = -1; return; }
        int dev = 0, cus = 0, per_cu = 0;
        if (hipGetDevice(&dev) != hipSuccess || hipDeviceGetAttribute(&cus, hipDeviceAttributeMultiprocessorCount, dev) != hipSuccess) { grid = -1; return; }
        if (hipFuncSetAttribute((const void*)mk_fwd, hipFuncAttributeMaxDynamicSharedMemorySize, LDS_BYTES) != hipSuccess) { fprintf(stderr, "kernel_launch: hipFuncSetAttribute failed\n"); grid = -1; return; }
        if (hipOccupancyMaxActiveBlocksPerMultiprocessor(&per_cu, (const void*)mk_fwd, NTHR, LDS_BYTES) != hipSuccess || per_cu < 1) { fprintf(stderr, "kernel_launch: occupancy query reports %d\n", per_cu); }
        (void)hipGetLastError();
        grid = cus;
    }
    if (grid < 0) return;
    if (hipMemsetAsync((char*)d_ws + WS_CTL, 0, CTL_ZERO_BYTES, stream) != hipSuccess) return;
    Args a{};
    for (int i = 0; i < 19; ++i) a.in[i] = (const float*)d_in[i];
    a.out = (float*)d_out; a.ws = (unsigned char*)d_ws; a.pad = 0;
#if MK_FUSED
    a.ph_lo = 0; a.ph_hi = NPH; a.li = 0;
    hipLaunchKernelGGL(mk_fwd, dim3(grid), dim3(NTHR), LDS_BYTES, stream, a);
#else
#ifndef PROBE_REPMASK
#define PROBE_REPMASK 0u
#endif
    for (int p = 0; p < NPH; ++p) { const int reps = ((PROBE_REPMASK >> p) & 1u) ? 2 : 1;
        for (int r = 0; r < reps; ++r) { a.ph_lo = p; a.ph_hi = p + 1; a.li = 0; hipLaunchKernelGGL(mk_fwd, dim3(grid), dim3(NTHR), LDS_BYTES, stream, a); } }
#endif
}
```

```cpp
#include <hip/hip_runtime.h>
#include <cstdio>
#include <cstdint>
namespace pg8 {
#define PG8_LAS __attribute__((address_space(3)))
typedef unsigned short bf16_t;
typedef short bf16x8 __attribute__((ext_vector_type(8)));
typedef float f32x4 __attribute__((ext_vector_type(4)));
typedef unsigned u32x4 __attribute__((ext_vector_type(4)));
typedef int i32x8 __attribute__((ext_vector_type(8)));
__device__ __forceinline__ const char* uptr(const char* p) { const unsigned long long v = (unsigned long long)p;
    const unsigned lo = (unsigned)__builtin_amdgcn_readfirstlane((int)(unsigned)v), hi = (unsigned)__builtin_amdgcn_readfirstlane((int)(unsigned)(v >> 32)); return (const char*)(((unsigned long long)hi << 32) | lo); }
__device__ __forceinline__ void mfma_f8_inplace(f32x4& c, i32x8 a, i32x8 b) { asm volatile("v_mfma_f32_16x16x128_f8f6f4 %0, %1, %2, %0" : "+v"(c) : "v"(a), "v"(b)); }
template <bool OFFS> __device__ __forceinline__ auto tile_pos(const char* base) { if constexpr (OFFS) return 0u; else return base; }
__device__ __forceinline__ void glds_sa(unsigned voff, const void* sbase, unsigned lds_dst) { unsigned keep;
    asm volatile("s_mov_b32 %0, m0\n\ts_mov_b32 m0, %2\n\ts_nop 0\n\tglobal_load_lds_dwordx4 %1, %3\n\ts_mov_b32 m0, %0" : "=&s"(keep) : "v"(voff), "s"(lds_dst), "s"(sbase) : "memory"); }
constexpr int BM = 256, BK = 64, HALF = 128, HTB = HALF * BK * 2  , STAGE_BYTES = 8 * HTB, NXCD = 8, WGM = 8;

__host__ __device__ __forceinline__ int lds_byte(int r, int c) { const int st = (r >> 4) * 2 + (c >> 5), rr = r & 15, cc = c & 31, ob = rr * 64 + cc * 2; return st * 1024 + (ob ^ (((ob >> 9) & 1) << 5)); }
__host__ __device__ __forceinline__ void stage_rc(int b, int& R, int& C) { const int st = b / 1024, sb = b % 1024, swz = sb ^ (((sb >> 9) & 1) << 5); R = (st >> 1) * 16 + swz / 64; C = (st & 1) * 32 + (swz % 64) / 2; }
__host__ __device__ __forceinline__ int perm32(int rho) { const int n = rho >> 4, i = rho & 15; return 8 * (i >> 2) + 4 * n + (i & 3); }

struct Unit { int pm, pn; };
struct Gemm { const bf16_t* A; const bf16_t* Bt; int M, N, K; };

struct StaticOrder {
    int nM, nN, nwg, G, c;
    __host__ __device__ void init(int M, int N, int G_, int c_) { nM = M / BM; nN = N / BM; nwg = nM * nN; G = G_; c = c_; }
    __host__ __device__ bool next(int i, Unit& u) const {
        const long L = (long)i * G + c; if (L >= nwg) return false;
        int wgid = (int)L; { const int q = nwg / NXCD, r = nwg % NXCD, xcd = wgid % NXCD, off = wgid / NXCD; wgid = (xcd < r ? xcd * (q + 1) : r * (q + 1) + (xcd - r) * q) + off; }
        const int nig = WGM * nN, gid = wgid / nig, fm = gid * WGM, gsz = (nM - fm) < WGM ? (nM - fm) : WGM;
        u.pm = fm + ((wgid % nig) % gsz); u.pn = (wgid % nig) / gsz; return true;
    }
    __device__ __forceinline__ void a_ready(const Unit&) const {}
    __device__ __forceinline__ void done(const Unit&) const {}
};

__device__ __forceinline__ unsigned cvt_pk_bf16(float lo, float hi) { unsigned r; asm volatile("v_cvt_pk_bf16_f32 %0, %1, %2" : "=v"(r) : "v"(lo), "v"(hi)); return r; }
typedef float f32x2 __attribute__((ext_vector_type(2)));
template <class Epi, class Sched, bool ALIGN_EPI = false, bool SP2 = false, bool F8 = false, bool SA = F8>
__device__ __forceinline__ void gemm_phase(PG8_LAS unsigned char* lds, const Gemm g, const Sched& S, const Epi& E) {
    int tid = threadIdx.x; asm volatile("" : "+v"(tid));
    const int wid = __builtin_amdgcn_readfirstlane(tid >> 6), lane = tid & 63, wr = wid >> 2, wc = wid & 3, fr = lane & 15, fq = lane >> 4;
    const int K = g.K, nt = K / BK;
    unsigned voffA[2], voffB[2];
#pragma unroll
    for (int i = 0; i < 2; ++i) { int R, C; stage_rc(tid * 16 + i * 8192, R, C); const int Rb = Epi::PERM ? ((R & ~31) + perm32(R & 31)) : R;
        voffA[i] = (unsigned)(R * K + C) * 2u; voffB[i] = (unsigned)(Rb * K + C) * 2u; }
    const unsigned kstep = (unsigned)(BK * 2);
    const unsigned hstep = (unsigned)HALF * (unsigned)K * 2u;
    const unsigned tstep = 2u * hstep;
    const unsigned ldsu = (unsigned)__builtin_amdgcn_readfirstlane((int)((unsigned)(uintptr_t)lds + (unsigned)wid * 1024u)); (void)ldsu;
    const unsigned ldsw = (unsigned)wid * 1024u;
    const int aoff = lds_byte(wr * 64 + fr, fq * 8), boff = lds_byte(wc * 32 + fr, fq * 8);
#define PG8_SA(b, h) (((b) * 2 + (h)) * HTB)
#define PG8_SB(b, h) ((4 + (b) * 2 + (h)) * HTB)
#define PG8_HOF(bufoff) (((((bufoff) / HTB) & 1) != 0) ? hstep : 0u)
#define PG8_STAGE(bufoff, gbase, voff) do { _Pragma("unroll") for (int _i = 0; _i < 2; ++_i) { \
        if constexpr (SA) glds_sa((voff)[_i] + (gbase), ((bufoff) < 4 * HTB) ? (((((bufoff) / HTB) & 1) != 0) ? gAh : gA) : (((((bufoff) / HTB) & 1) != 0) ? gBh : gB), ldsu + (unsigned)((bufoff) + _i * 8192)); \
        else __builtin_amdgcn_global_load_lds((const unsigned*)((gbase) + PG8_HOF(bufoff) + (voff)[_i]), (PG8_LAS unsigned*)(lds + (bufoff) + ldsw + _i * 8192), 16, 0, 0); } } while (0)
#define PG8_LDA(dst, b, h) do { _Pragma("unroll") for (int m = 0; m < 4; ++m) _Pragma("unroll") for (int k = 0; k < 2; ++k) dst[m][k] = *(const PG8_LAS bf16x8*)(lds + PG8_SA(b, h) + aoff + m * 2048 + k * 1024); } while (0)
#define PG8_LDB(dst, b, h) do { _Pragma("unroll") for (int n = 0; n < 2; ++n) _Pragma("unroll") for (int k = 0; k < 2; ++k) dst[n][k] = *(const PG8_LAS bf16x8*)(lds + PG8_SB(b, h) + boff + n * 2048 + k * 1024); } while (0)
#define PG8_CAT(x) __builtin_bit_cast(i32x8, __builtin_shufflevector((x)[0], (x)[1], 0, 1, 2, 3, 4, 5, 6, 7, 8, 9, 10, 11, 12, 13, 14, 15))
#define PG8_MMA(ai, bj, At, Bt) do { __builtin_amdgcn_s_setprio(1); _Pragma("unroll") for (int m = 0; m < 4; ++m) _Pragma("unroll") for (int n = 0; n < 2; ++n) { \
        if constexpr (F8) mfma_f8_inplace(acc[ai][bj][m][n], PG8_CAT(Bt[n]), PG8_CAT(At[m])); \
        else { _Pragma("unroll") for (int k = 0; k < 2; ++k) acc[ai][bj][m][n] = __builtin_amdgcn_mfma_f32_16x16x32_bf16(Bt[n][k], At[m][k], acc[ai][bj][m][n], 0, 0, 0); } } __builtin_amdgcn_s_setprio(0); } while (0)
#define PG8_WAIT_V(n) asm volatile("s_waitcnt vmcnt(" #n ")" ::: "memory")
#define PG8_WAIT_L(n) asm volatile("s_waitcnt lgkmcnt(" #n ")" ::: "memory")
#define PG8_BAR __builtin_amdgcn_s_barrier()
#define PG8_SCHED __builtin_amdgcn_sched_barrier(0)
    const char* const gA = uptr((const char*)g.A); const char* const gB = uptr((const char*)g.Bt); const char* const gAh = uptr((const char*)g.A + hstep); const char* const gBh = uptr((const char*)g.Bt + hstep); (void)gA; (void)gB; (void)gAh; (void)gBh;
    using TP = __typeof__(tile_pos<SA>((const char*)nullptr));
    Unit cur, nxt; int ui = 0;
    if (!S.next(0, cur)) return;
    cur.pm = __builtin_amdgcn_readfirstlane(cur.pm); cur.pn = __builtin_amdgcn_readfirstlane(cur.pn);
    f32x4 acc[2][2][4][2];
#pragma unroll
    for (int a = 0; a < 2; ++a)
#pragma unroll
        for (int b = 0; b < 2; ++b)
#pragma unroll
            for (int m = 0; m < 4; ++m)
#pragma unroll
                for (int n = 0; n < 2; ++n) acc[a][b][m][n] = (f32x4){0.f, 0.f, 0.f, 0.f};
    bf16x8 At[4][2], B0[2][2], B1[2][2];
    TP cA = tile_pos<SA>((const char*)g.A) + (unsigned)cur.pm * tstep; TP cB = tile_pos<SA>((const char*)g.Bt) + (unsigned)cur.pn * tstep;
    S.a_ready(cur);
    if constexpr (Epi::KSCALE) E.prep(cur, 0, wid, lane);
    if constexpr (SP2) {
        PG8_STAGE(PG8_SB(0, 0), cB, voffB); PG8_STAGE(PG8_SB(0, 1), cB, voffB); PG8_STAGE(PG8_SA(0, 0), cA, voffA); PG8_STAGE(PG8_SA(0, 1), cA, voffA);
        if (wr == 1) PG8_BAR;
        PG8_WAIT_V(2); PG8_BAR;
        PG8_STAGE(PG8_SB(1, 0), cB + kstep, voffB); PG8_STAGE(PG8_SA(1, 0), cA + kstep, voffA); PG8_STAGE(PG8_SB(1, 1), cB + kstep, voffB);
        PG8_WAIT_V(6); PG8_BAR;
    } else {
        PG8_STAGE(PG8_SB(0, 0), cB, voffB); PG8_STAGE(PG8_SA(0, 0), cA, voffA); PG8_STAGE(PG8_SB(0, 1), cB, voffB); PG8_STAGE(PG8_SA(0, 1), cA, voffA);
        if (wr == 1) PG8_BAR;
        PG8_WAIT_V(4); PG8_BAR;
        PG8_STAGE(PG8_SB(1, 0), cB + kstep, voffB); PG8_STAGE(PG8_SA(1, 0), cA + kstep, voffA); PG8_STAGE(PG8_SB(1, 1), cB + kstep, voffB);
        PG8_WAIT_V(6); PG8_BAR;
    }
    for (;;) {
        const bool has_next = S.next(ui + 1, nxt);
        nxt.pm = __builtin_amdgcn_readfirstlane(nxt.pm); nxt.pn = __builtin_amdgcn_readfirstlane(nxt.pn);
        const TP nA = has_next ? tile_pos<SA>((const char*)g.A) + (unsigned)nxt.pm * tstep : cA; const TP nB = has_next ? tile_pos<SA>((const char*)g.Bt) + (unsigned)nxt.pn * tstep : cB;
#pragma unroll 1
        for (int t = 0; t < nt; t += 2) {
            const bool last = (t == nt - 2);
            const TP a1 = cA + (unsigned)(t + 1) * kstep;
            const TP a2 = last ? nA : cA + (unsigned)(t + 2) * kstep; const TP b2 = last ? nB : cB + (unsigned)(t + 2) * kstep;
            const TP a3 = a2 + kstep; const TP b3 = b2 + kstep;
            if (last && has_next) { S.a_ready(nxt); if constexpr (Epi::KSCALE) E.prep(nxt, (ui + 1) & 1, wid, lane); }
            if constexpr (Epi::KSCALE) { if (t == 4 || t == 8) E.kscale(acc, ui & 1, t == 4 ? 0 : 1, wr, fr); }
            if constexpr (SP2) {
            PG8_LDB(B0, 0, 0); PG8_LDB(B1, 0, 1); PG8_SCHED; PG8_LDA(At, 0, 0); PG8_STAGE(PG8_SA(1, 1), a1, voffA);
            PG8_WAIT_V(8); PG8_WAIT_L(0); PG8_BAR; PG8_MMA(0, 0, At, B0); PG8_MMA(0, 1, At, B1); PG8_BAR; PG8_SCHED;
            PG8_LDA(At, 0, 1); PG8_STAGE(PG8_SB(0, 0), b2, voffB); PG8_STAGE(PG8_SB(0, 1), b2, voffB); PG8_STAGE(PG8_SA(0, 0), a2, voffA);
            PG8_WAIT_V(8); PG8_WAIT_L(0); PG8_BAR; PG8_MMA(1, 0, At, B0); PG8_MMA(1, 1, At, B1); PG8_BAR; PG8_SCHED;
            PG8_LDB(B0, 1, 0); PG8_LDB(B1, 1, 1); PG8_SCHED; PG8_LDA(At, 1, 0); PG8_STAGE(PG8_SA(0, 1), a2, voffA);
            PG8_WAIT_V(8); PG8_WAIT_L(0); PG8_BAR; PG8_MMA(0, 0, At, B0); PG8_MMA(0, 1, At, B1); PG8_BAR; PG8_SCHED;
            PG8_LDA(At, 1, 1); PG8_STAGE(PG8_SB(1, 0), b3, voffB); PG8_STAGE(PG8_SB(1, 1), b3, voffB); PG8_STAGE(PG8_SA(1, 0), a3, voffA);
            PG8_WAIT_V(8); PG8_WAIT_L(0); PG8_BAR; PG8_MMA(1, 0, At, B0); PG8_MMA(1, 1, At, B1); PG8_BAR; PG8_SCHED;
            } else {
            PG8_LDB(B0, 0, 0); PG8_SCHED; PG8_LDA(At, 0, 0); PG8_STAGE(PG8_SA(1, 1), a1, voffA);
            PG8_WAIT_L(8); PG8_BAR; PG8_WAIT_L(0); PG8_MMA(0, 0, At, B0); PG8_BAR; PG8_SCHED;
            PG8_LDB(B1, 0, 1); PG8_STAGE(PG8_SB(0, 0), b2, voffB);
            PG8_BAR; PG8_WAIT_L(0); PG8_MMA(0, 1, At, B1); PG8_BAR;
            PG8_LDA(At, 0, 1); PG8_STAGE(PG8_SA(0, 0), a2, voffA);
            PG8_BAR; PG8_WAIT_L(0); PG8_MMA(1, 0, At, B0); PG8_BAR; PG8_SCHED;
            PG8_STAGE(PG8_SB(0, 1), b2, voffB);
            PG8_WAIT_V(6); PG8_BAR; PG8_MMA(1, 1, At, B1); PG8_BAR;
            PG8_LDB(B0, 1, 0); PG8_SCHED; PG8_LDA(At, 1, 0); PG8_STAGE(PG8_SA(0, 1), a2, voffA);
            PG8_WAIT_L(8); PG8_BAR; PG8_WAIT_L(0); PG8_MMA(0, 0, At, B0); PG8_BAR; PG8_SCHED;
            PG8_LDB(B1, 1, 1); PG8_STAGE(PG8_SB(1, 0), b3, voffB);
            PG8_BAR; PG8_WAIT_L(0); PG8_MMA(0, 1, At, B1); PG8_BAR;
            PG8_LDA(At, 1, 1); PG8_STAGE(PG8_SA(1, 0), a3, voffA);
            PG8_BAR; PG8_WAIT_L(0); PG8_MMA(1, 0, At, B0); PG8_BAR; PG8_SCHED;
            PG8_STAGE(PG8_SB(1, 1), b3, voffB);
            PG8_WAIT_V(6); PG8_BAR; PG8_MMA(1, 1, At, B1); PG8_BAR;
            }
        }
        if constexpr (F8) asm volatile("s_nop 15\n\ts_nop 15" ::: "memory");
        if constexpr (ALIGN_EPI) { if (wr == 0) PG8_BAR; }
        if constexpr (Epi::KSCALE) E.kscale(acc, ui & 1, 2, wr, fr);
        if constexpr (!Epi::AFTER_DRAIN) { E(acc, cur, wr, wc, fr, fq); S.done(cur); }
        if (!has_next) break;
#pragma unroll
        for (int a = 0; a < 2; ++a)
#pragma unroll
            for (int b = 0; b < 2; ++b)
#pragma unroll
                for (int m = 0; m < 4; ++m)
#pragma unroll
                    for (int n = 0; n < 2; ++n) acc[a][b][m][n] = (f32x4){0.f, 0.f, 0.f, 0.f};
        cur = nxt; cA = nA; cB = nB; ++ui;
        if constexpr (ALIGN_EPI) { if (wr == 1) PG8_BAR; }
    }
    PG8_WAIT_V(0);
    if constexpr (!ALIGN_EPI) { if (wr == 0) PG8_BAR; }
    PG8_BAR;
    if constexpr (Epi::AFTER_DRAIN) { E.fused(acc, cur, wr, wc, fr, fq, lds, wid, lane); S.done(cur); }
#undef PG8_SA
#undef PG8_SB
#undef PG8_STAGE
#undef PG8_HOF
#undef PG8_LDA
#undef PG8_LDB
#undef PG8_MMA
#undef PG8_CAT
#undef PG8_WAIT_V
#undef PG8_WAIT_L
#undef PG8_BAR
#undef PG8_SCHED
}
}
#define LAS __attribute__((address_space(3)))
#define XB_TMO      128
#define XB_XCNT(j)  (256  + 64 * (j))
#define XB_XSUB(j)  (1280 + 64 * (j))
#define XB_XGEN(j)  (2304 + 64 * (j))
#define XB_TOP      3328
#define XB_TOPGEN   3392
#define XCD_BAR_WORDS 3456
#define XB_SPIN_CAP (1u << 18)

__device__ __forceinline__ unsigned xb_ld(unsigned* p)              { return __hip_atomic_load(p, __ATOMIC_RELAXED, __HIP_MEMORY_SCOPE_AGENT); }
__device__ __forceinline__ unsigned xb_add(unsigned* p, unsigned v) { return __hip_atomic_fetch_add(p, v, __ATOMIC_RELAXED, __HIP_MEMORY_SCOPE_AGENT); }
__device__ __forceinline__ unsigned xb_xcc_id() { return (unsigned)__builtin_amdgcn_s_getreg((3 << 11) | 20) & 0xFu; }
#define XB_SPIN(cond, bar) do { unsigned _sp = 0; while (cond) { __builtin_amdgcn_s_sleep(1); \
    if ((++_sp & 255u) == 0u) { if (xb_ld(&(bar)[XB_TMO])) break; if (_sp > XB_SPIN_CAP) { atomicAdd(&(bar)[XB_TMO], 1u); break; } } } } while (0)

struct XcdBarrier {
    unsigned* bar; unsigned x;
    volatile LAS unsigned* st;
};

__device__ __forceinline__ XcdBarrier xcd_barrier_post(unsigned* bar, volatile LAS unsigned* st) {
    XcdBarrier b; b.bar = bar; b.x = xb_xcc_id(); b.st = st;
    if (threadIdx.x == 0) (void)xb_add(&bar[XB_XCNT(b.x)], 1u);
    return b;
}
__device__ __forceinline__ void xcd_barrier_complete(unsigned* bar, unsigned x, unsigned& nloc, unsigned& nx) {
    const unsigned G = gridDim.x * gridDim.y * gridDim.z;
    unsigned sum, cnt, mine, sp = 0u;
    for (;;) {
        sum = 0u; cnt = 0u; mine = 0u;
#pragma unroll
        for (unsigned j = 0; j < 16; ++j) { const unsigned c = xb_ld(&bar[XB_XCNT(j)]); sum += c; cnt += (c > 0u) ? 1u : 0u; mine = (j == x) ? c : mine; }
        if (sum == G) break;
        __builtin_amdgcn_s_sleep(1);
        if ((++sp & 255u) == 0u) { if (xb_ld(&bar[XB_TMO])) break; if (sp > XB_SPIN_CAP) { atomicAdd(&bar[XB_TMO], 1u); break; } }
    }
    nloc = mine > 0u ? mine : 1u; nx = cnt > 0u ? cnt : 1u;
}

__device__ __forceinline__ void xcd_barrier(const XcdBarrier& b) {
    asm volatile("s_waitcnt vmcnt(0)" ::: "memory");
    __syncthreads();
    if (threadIdx.x == 0) {
        unsigned* bar = b.bar;
        __builtin_amdgcn_s_waitcnt(0);
        unsigned nloc = b.st[0], nx = b.st[1];
        if (nloc == 0u) { xcd_barrier_complete(bar, b.x, nloc, nx); b.st[0] = nloc; b.st[1] = nx; }
        const unsigned old = xb_add(&bar[XB_XSUB(b.x)], 1u);
        const unsigned gen = old / nloc;
        if (old + 1u == (gen + 1u) * nloc) {
            __builtin_amdgcn_fence(__ATOMIC_RELEASE, "agent");
            asm volatile("s_waitcnt vmcnt(0)" ::: "memory");
            const unsigned og = xb_add(&bar[XB_TOP], 1u);
            const unsigned tg = og / nx;
            if (og + 1u == (tg + 1u) * nx) xb_add(&bar[XB_TOPGEN], 1u);
            else XB_SPIN(xb_ld(&bar[XB_TOPGEN]) == tg, bar);
            __builtin_amdgcn_fence(__ATOMIC_ACQUIRE, "agent");
            xb_add(&bar[XB_XGEN(b.x)], 1u);
            asm volatile("s_waitcnt vmcnt(0)" ::: "memory");
        } else {
            XB_SPIN(xb_ld(&bar[XB_XGEN(b.x)]) == gen, bar);
            __builtin_amdgcn_fence(__ATOMIC_ACQUIRE, "agent");
            asm volatile("s_waitcnt vmcnt(0)" ::: "memory");
        }
    }
    __syncthreads();
}
#ifndef MK_FUSED
#define MK_FUSED 1
#endif
constexpr int NB = 32, SEQ = 2048, DM = 1024, MTOK = NB * SEQ, NLAYER = 2, DFF = 2816, IN_W = 1956;
constexpr float RMS_EPS = 1e-6f, LOG2E = 1.4426950408889634f;
constexpr float C2_64 = 0.125f * LOG2E, C2_96 = 0.10206207261596577f * LOG2E;
constexpr int NWAVES = 8, NTHR = 512;
typedef float f32x2 __attribute__((ext_vector_type(2)));
typedef float f32x16 __attribute__((ext_vector_type(16)));
typedef unsigned u32x2 __attribute__((ext_vector_type(2)));

constexpr size_t MiB = 1u << 20;
constexpr size_t WS_CTL = 0, CTL_ZERO_BYTES = 1 * MiB;
constexpr size_t WS_CMOD = 1 * MiB;
constexpr size_t WS_ROPE = 3 * MiB;
constexpr size_t WS_TB = 3 * MiB + 512 * 1024;
constexpr size_t WS_PSUM = 3 * MiB + 512 * 1024 + 4096;
constexpr size_t WS_KMP = 4 * MiB;
constexpr size_t WS_LOGF = 5 * MiB;
constexpr size_t WS_CQSS = 6 * MiB;
constexpr size_t WS_CKVSS = 7 * MiB;
constexpr size_t WS_YSS = 8 * MiB;
constexpr size_t WS_OSS = 12 * MiB;
constexpr size_t WS_KMF = WS_YSS;
constexpr size_t WS_F = WS_LOGF;
constexpr size_t WS_W = 16 * MiB, W_LAYER = 24 * MiB;
constexpr size_t WO_IN = 0, WO_UQ = 4 * MiB, WO_UKV = 4 * MiB + 512 * 1024, WO_OUT = 5 * MiB, WO_GU = 7 * MiB, WO_DN = 18 * MiB;
constexpr size_t WS_H = 64 * MiB;
constexpr size_t WS_QF = 192 * MiB, WS_KF = 232 * MiB, WS_VF = 272 * MiB, WS_QM = 304 * MiB, WS_KM = 336 * MiB, WS_VM = 368 * MiB;
constexpr size_t WS_CQ = 400 * MiB, WS_T7 = 432 * MiB, WS_QC = 464 * MiB, WS_KC = 560 * MiB, WS_VC = 656 * MiB;
constexpr size_t WS_ACT = 192 * MiB;
constexpr size_t WS_ACT8 = 544 * MiB;
constexpr size_t WS_DN8 = 976 * MiB, DN8_LAYER = 3 * MiB;
constexpr int PM8_L0 = 256, PM8_L1 = 256;
constexpr float ACT_SC = 4.f, WDN_SC = 512.f, DN_OSC = 1.f / (ACT_SC * WDN_SC);
constexpr size_t WS_KR = 624 * MiB;
constexpr size_t WS_O = 720 * MiB, WS_Y = WS_H  , WS_XB = 848 * MiB  , WS_END = 982 * MiB;
constexpr int CW_BAR = 4096;

constexpr int RING_BYTES = 131072, MISC_OFF = RING_BYTES + 320, LDS_BYTES = 147456;

#define GAS __attribute__((address_space(1)))
typedef unsigned short bf16;
typedef unsigned v4u __attribute__((ext_vector_type(4)));
typedef pg8::f32x4 f32x4;
typedef pg8::bf16x8 bf16x8;
#define LDS_WAIT() asm volatile("s_waitcnt lgkmcnt(0)" ::: "memory")
#define VM_WAIT() asm volatile("s_waitcnt vmcnt(0)" ::: "memory")

typedef __bf16 bf16x2_t __attribute__((ext_vector_type(2)));
__device__ __forceinline__ unsigned pk2(float lo, float hi) { f32x2 v = {lo, hi}; bf16x2_t b = __builtin_convertvector(v, bf16x2_t); return __builtin_bit_cast(unsigned, b); }
__device__ __forceinline__ float bf2f(unsigned short h) { return __uint_as_float((unsigned)h << 16); }
__device__ __forceinline__ unsigned short f2bf1(float f) { return (unsigned short)(pk2(f, 0.f) & 0xffffu); }
__device__ __forceinline__ v4u pack8(f32x4 a, f32x4 b) { v4u w; w.x = pk2(a[0], a[1]); w.y = pk2(a[2], a[3]); w.z = pk2(b[0], b[1]); w.w = pk2(b[2], b[3]); return w; }
template <int CTRL> __device__ __forceinline__ float dpp_mov(float v) { return __int_as_float(__builtin_amdgcn_update_dpp(0, __float_as_int(v), CTRL, 0xF, 0xF, true)); }
__device__ __forceinline__ float sum8(float v) { v += dpp_mov<0xB1>(v); v += dpp_mov<0x4E>(v); v += dpp_mov<0x141>(v); return v; }
__device__ __forceinline__ float sum16(float v) { v = sum8(v); v += dpp_mov<0x140>(v); return v; }
__device__ __forceinline__ float sum_rows(float v) {
    auto a = __builtin_amdgcn_permlane16_swap(__float_as_uint(v), __float_as_uint(v), false, false); v = __uint_as_float(a[0]) + __uint_as_float(a[1]);
    auto b = __builtin_amdgcn_permlane32_swap(__float_as_uint(v), __float_as_uint(v), false, false); return __uint_as_float(b[0]) + __uint_as_float(b[1]); }
__device__ __forceinline__ float wave_sum(float v) { return sum_rows(sum16(v)); }
__device__ __forceinline__ float other_half(float v, int upper) {
    auto b = __builtin_amdgcn_permlane32_swap(__float_as_uint(v), __float_as_uint(v), false, false); return __uint_as_float(upper ? b[0] : b[1]); }
__device__ __forceinline__ float fast_rsqrt(float x) { return __builtin_amdgcn_rsqf(x); }

__device__ __forceinline__ unsigned char* ws_at(unsigned char* base, unsigned long long off) { asm volatile("" : "+s"(off)); return base + off; }
__device__ __forceinline__ int map_src(int map, int n) {
    if (map == 0) {
        const int t = n >> 8, c = n & 255;
        if (t < 3) return t * 256 + c;
        if (t < 6) return 772 + (t - 3) * 256 + c;
        if (t == 6) return 1540 + c;
        if (c < 128) return 1796 + c;
        if (c < 160) return 1924 + (c - 128);
        if (c < 164) return 768 + (c - 160);
        return -1;
    }
    if (map == 2) { const int t = n >> 8, c = n & 255; return c < 128 ? 128 * t + c : DFF + 128 * t + (c - 128); }
    return n;
}
__device__ __forceinline__ void prep_item(const float* W, int Ksrc, int Nsrc, bf16* WT, int Kdst, int map, const float* kscale, LAS float* scr, int kb, int nb, int lane) {
    const int k0 = 64 * kb, n0 = 32 * nb;
    const int sc = map_src(map, n0 + (lane & 31));
    float wv[32];
#pragma unroll
    for (int i = 0; i < 32; ++i) { const int k = k0 + 2 * i + (lane >> 5); wv[i] = (sc >= 0 && k < Ksrc) ? W[(size_t)k * Nsrc + sc] : 0.f; }
    if (kscale) {
#pragma unroll
        for (int i = 0; i < 32; ++i) { const int k = k0 + 2 * i + (lane >> 5); if (k < Ksrc) wv[i] *= kscale[k]; } }
    const float nsc = (map == 3) ? WDN_SC : (map == 2) ? ((((n0 + (lane & 31)) & 255) < 128) ? -1.4426950408889634f : -0.6931471805599453f * ACT_SC) : 1.f;
#pragma unroll
    for (int i = 0; i < 32; ++i) scr[(2 * i + (lane >> 5)) * 33 + (lane & 31)] = wv[i] * nsc;
    LDS_WAIT(); asm volatile("" ::: "memory");
    const int c = lane & 7;
#pragma unroll
    for (int j = 0; j < 4; ++j) { const int n = (lane >> 3) + 8 * j; const LAS float* s = scr + (8 * c) * 33 + n;
        v4u o; o.x = pk2(s[0 * 33], s[1 * 33]); o.y = pk2(s[2 * 33], s[3 * 33]); o.z = pk2(s[4 * 33], s[5 * 33]); o.w = pk2(s[6 * 33], s[7 * 33]);
        *(GAS v4u*)(WT + (size_t)(n0 + n) * Kdst + k0 + 8 * c) = o; }
    LDS_WAIT(); asm volatile("" ::: "memory");
}

__device__ __forceinline__ void prep_item8(const float* W, int Nsrc, unsigned char* WT, int Kdst, float sc, LAS float* scr, int kb, int nb, int lane) {
    const int k0 = 64 * kb, n0 = 32 * nb;
    float wv[32];
#pragma unroll
    for (int i = 0; i < 32; ++i) wv[i] = W[(size_t)(k0 + 2 * i + (lane >> 5)) * Nsrc + n0 + (lane & 31)];
#pragma unroll
    for (int i = 0; i < 32; ++i) scr[(2 * i + (lane >> 5)) * 33 + (lane & 31)] = wv[i] * sc;
    LDS_WAIT(); asm volatile("" ::: "memory");
    const int c = lane & 3;
#pragma unroll
    for (int j = 0; j < 2; ++j) { const int n = (lane >> 2) + 16 * j; const LAS float* s = scr + (16 * c) * 33 + n; v4u o;
#pragma unroll
        for (int q = 0; q < 4; ++q) { int w = __builtin_amdgcn_cvt_pk_fp8_f32(s[(4 * q) * 33], s[(4 * q + 1) * 33], 0, false); w = __builtin_amdgcn_cvt_pk_fp8_f32(s[(4 * q + 2) * 33], s[(4 * q + 3) * 33], w, true); o[q] = (unsigned)w; }
        *(GAS v4u*)(WT + (size_t)(n0 + n) * Kdst + k0 + 16 * c) = o; }
    LDS_WAIT(); asm volatile("" ::: "memory");
}

__device__ __forceinline__ int t5_bucket_dev(int n) {
    if (n < 16) return n;
    int c = 15;
    c += (n >= 16); c += (n >= 19); c += (n >= 21); c += (n >= 24); c += (n >= 27); c += (n >= 31); c += (n >= 35); c += (n >= 40);
    c += (n >= 46); c += (n >= 52); c += (n >= 59); c += (n >= 67); c += (n >= 77); c += (n >= 87); c += (n >= 99); c += (n >= 113);
    return c;
}
__device__ __forceinline__ void sincos_acc(float ang, float& c, float& s) {
    const double a = (double)ang; const double q = __builtin_rint(a * 0.63661977236758134308); const double r = __builtin_fma(-q, 1.57079632679489661923, a) - q * 6.123233995736766e-17;
    const double r2 = r * r;
    double sp = -7.6471637318198164759e-13; sp = sp * r2 + 1.6059043836821614599e-10; sp = sp * r2 - 2.5052108385441718775e-08; sp = sp * r2 + 2.7557319223985890653e-06;
    sp = sp * r2 - 1.9841269841269841270e-04; sp = sp * r2 + 8.3333333333333333333e-03; sp = sp * r2 - 1.6666666666666666667e-01; const double sn = r + r * r2 * sp;
    double cp = 4.7794773323873852974e-14; cp = cp * r2 - 1.1470745597729724714e-11; cp = cp * r2 + 2.0876756987868098979e-09; cp = cp * r2 - 2.7557319223985890653e-07;
    cp = cp * r2 + 2.4801587301587301587e-05; cp = cp * r2 - 1.3888888888888888889e-03; cp = cp * r2 + 4.1666666666666666667e-02; cp = cp * r2 - 0.5; const double cs = 1.0 + r2 * cp;
    const int qi = ((int)q) & 3;
    const double cc = (qi == 0) ? cs : (qi == 1) ? -sn : (qi == 2) ? -cs : sn;
    const double ss = (qi == 0) ? sn : (qi == 1) ? cs : (qi == 2) ? -sn : -cs;
    c = (float)cc; s = (float)ss;
}
__device__ __forceinline__ float rope_invfreq(int i) {
    const float t[16] = {0x1.000000p+0f, 0x1.1feb34p-1f, 0x1.43d136p-2f, 0x1.6c310ep-3f, 0x1.99999ap-4f, 0x1.ccab84p-5f, 0x1.030dc6p-5f, 0x1.235a72p-6f, 0x1.47ae14p-7f, 0x1.708938p-8f, 0x1.9e7c70p-9f, 0x1.d22a50p-10f, 0x1.0624dep-10f, 0x1.26d42cp-11f, 0x1.4b96c0p-12f, 0x1.74eea6p-13f};
    float r = t[0];
#pragma unroll
    for (int k = 1; k < 16; ++k) r = (i == k) ? t[k] : r;
    return r;
}

constexpr int RPI = 4;
__device__ __forceinline__ f32x4 bf4_to_f32(u32x2 w) { f32x4 r; r.x = __uint_as_float(w.x << 16); r.y = __uint_as_float(w.x & 0xffff0000u); r.z = __uint_as_float(w.y << 16); r.w = __uint_as_float(w.y & 0xffff0000u); return r; }
__device__ __forceinline__ float sq4(f32x4 v) { return (v.x * v.x + v.y * v.y) + (v.z * v.z + v.w * v.w); }
__device__ __forceinline__ void prenorm_rows(const float* x, const float* cmod_l  , int ipre, int ish, bf16* H, int gw, int NGW, int lane) {
    for (int ch = gw; ch < MTOK / 32; ch += NGW) {
        const int m0 = ch * 32, b = m0 >> 11;
        const GAS f32x4* prep = (const GAS f32x4*)(cmod_l + ((size_t)b * 6 + ipre) * DM) + lane;
        const GAS f32x4* shp = (const GAS f32x4*)(cmod_l + ((size_t)b * 6 + ish) * DM) + lane;
        f32x4 pre[4], sh[4];
#pragma unroll
        for (int j = 0; j < 4; ++j) { pre[j] = prep[64 * j]; sh[j] = shp[64 * j]; }
#pragma unroll 1
        for (int i = 0; i < 32; i += RPI) {
            f32x4 v[RPI][4];
#pragma unroll
            for (int r = 0; r < RPI; ++r) { const GAS f32x4* xr = (const GAS f32x4*)(x + (size_t)(m0 + i + r) * DM) + lane;
#pragma unroll
                for (int j = 0; j < 4; ++j) v[r][j] = __builtin_nontemporal_load(xr + 64 * j); }
#pragma unroll
            for (int r = 0; r < RPI; ++r) {
                const float rstd = fast_rsqrt(wave_sum((sq4(v[r][0]) + sq4(v[r][1])) + (sq4(v[r][2]) + sq4(v[r][3]))) * (1.f / DM) + RMS_EPS);
                GAS u32x2* o8 = (GAS u32x2*)(H + (size_t)(m0 + i + r) * DM) + lane;
#pragma unroll
                for (int j = 0; j < 4; ++j) { const f32x4 q = v[r][j] * rstd * pre[j] + sh[j]; u32x2 w; w.x = pk2(q.x, q.y); w.y = pk2(q.z, q.w); o8[64 * j] = w; }
            }
        }
    }
}
template <bool XIN_BF, bool XOUT_BF>
__device__ __forceinline__ void post_rows(const void* xin_, void* xout_, const bf16* Y, const float* YSS, float yeps, const float* cmod_l, int ipost,
                                          bool do_pre, const float* cmod_n, int ipre, int ish, bf16* H, int gw, int NGW, int lane) {
    constexpr int RP = XIN_BF ? 8 : RPI;
    const unsigned l8 = (unsigned)lane * 8u, l16 = (unsigned)lane * 16u;
#define LD8(base, j) __builtin_nontemporal_load((const GAS u32x2*)((const GAS char*)(base) + (l8 + (j) * 512u)))
#define LD16(base, j) __builtin_nontemporal_load((const GAS f32x4*)((const GAS char*)(base) + (l16 + (j) * 1024u)))
    for (int ch = gw; ch < MTOK / 32; ch += NGW) {
        const int m0 = ch * 32, b = m0 >> 11;
        const float* pop = cmod_l + ((size_t)b * 6 + ipost) * DM; const float* prep = cmod_n + ((size_t)b * 6 + ipre) * DM; const float* shp = cmod_n + ((size_t)b * 6 + ish) * DM;
        f32x4 po[4], pre[4], sh[4];
#pragma unroll
        for (int j = 0; j < 4; ++j) { po[j] = *(const GAS f32x4*)((const GAS char*)pop + (l16 + j * 1024u)); pre[j] = do_pre ? *(const GAS f32x4*)((const GAS char*)prep + (l16 + j * 1024u)) : po[j]; sh[j] = do_pre ? *(const GAS f32x4*)((const GAS char*)shp + (l16 + j * 1024u)) : po[j]; }
#pragma unroll 1
        for (int i = 0; i < 32; i += RP) {
            const size_t mc = (size_t)(m0 + i);
            f32x4 xf[XIN_BF ? 1 : RP][4]; u32x2 xb[XIN_BF ? RP : 1][4]; u32x2 yw[RP][4]; float rsy[RP];
#pragma unroll
            for (int r = 0; r < RP; ++r) {
                const bf16* yrow = Y + (mc + (r & ~1)) * DM;
                if (XIN_BF) { const bf16* xrow = (const bf16*)xin_ + (mc + (r & ~1)) * DM;
#pragma unroll
                    for (int j = 0; j < 4; ++j) { xb[XIN_BF ? r : 0][j] = LD8(xrow, (r & 1) * 4 + j); yw[r][j] = LD8(yrow, (r & 1) * 4 + j); } }
                else { const float* xrow = (const float*)xin_ + (mc + r) * DM;
#pragma unroll
                    for (int j = 0; j < 4; ++j) { xf[XIN_BF ? 0 : r][j] = LD16(xrow, j); yw[r][j] = LD8(yrow, (r & 1) * 4 + j); } }
                const GAS f32x4* ssp = (const GAS f32x4*)(YSS + (mc + r) * 16);
                const f32x4 s0 = ssp[0], s1 = ssp[1], s2 = ssp[2], s3 = ssp[3];
                rsy[r] = ((s0.x + s0.y) + (s0.z + s0.w)) + ((s1.x + s1.y) + (s1.z + s1.w)) + ((s2.x + s2.y) + (s2.z + s2.w)) + ((s3.x + s3.y) + (s3.z + s3.w)); }
#pragma unroll
            for (int r = 0; r < RP; ++r) {
                const float ry = fast_rsqrt(rsy[r] * (1.f / DM) + yeps);
                float s = 0.f; f32x4 v[4];
#pragma unroll
                for (int j = 0; j < 4; ++j) { const f32x4 xv = XIN_BF ? bf4_to_f32(xb[XIN_BF ? r : 0][j]) : xf[XIN_BF ? 0 : r][j];
                    v[j] = xv + po[j] * bf4_to_f32(yw[r][j]) * ry; s += sq4(v[j]);
                    if (XOUT_BF) { u32x2 w; w.x = pk2(v[j].x, v[j].y); w.y = pk2(v[j].z, v[j].w); __builtin_nontemporal_store(w, (GAS u32x2*)((GAS char*)((bf16*)xout_ + (mc + (r & ~1)) * DM) + (l8 + ((r & 1) * 4 + j) * 512u))); }
                    else __builtin_nontemporal_store(v[j], (GAS f32x4*)((GAS char*)((float*)xout_ + (mc + r) * DM) + (l16 + j * 1024u))); }
                if (do_pre) {
                    const float rstd = fast_rsqrt(wave_sum(s) * (1.f / DM) + RMS_EPS);
                    bf16* hrow = H + (mc + (r & ~1)) * DM;
#pragma unroll
                    for (int j = 0; j < 4; ++j) { const f32x4 q = v[j] * rstd * pre[j] + sh[j]; u32x2 w; w.x = pk2(q.x, q.y); w.y = pk2(q.z, q.w); *(GAS u32x2*)((GAS char*)hrow + (l8 + ((r & 1) * 4 + j) * 512u)) = w; }
                }
            }
        }
    }
#undef LD8
#undef LD16
}
template <int DKP, int NH>
__device__ __forceinline__ unsigned hm_off(int row, int head, int d) { return (unsigned)((((row >> 11) * NH + head) * SEQ + (row & (SEQ - 1))) * DKP + d); }
__device__ __forceinline__ void fox_scan(const float* LOGF, const float* PSUM, bf16* QF, bf16* KF, int gw, int NGW, int lane, LAS float* scr  ) {
    for (int task = gw; task < (MTOK / 256) * 4; task += NGW) {
        const int pm = task >> 2, h = task & 3, b = pm >> 3;
        float carry = 0.f;
        for (int p = b * 8; p < pm; ++p) carry += PSUM[(p * 2) * 4 + h] + PSUM[(p * 2 + 1) * 4 + h];
        const float* src = LOGF + ((size_t)pm * 256 + 4 * lane) * 4 + h;
        float lv[4];
#pragma unroll
        for (int i = 0; i < 4; ++i) lv[i] = src[4 * i];
        scr[lane] = (lv[0] + lv[1]) + (lv[2] + lv[3]); LDS_WAIT(); asm volatile("" ::: "memory");
        float run = carry;
#pragma unroll 16
        for (int i = 0; i < 64; ++i) { const float tv = scr[i]; run += (i < lane) ? tv : 0.f; }
        LDS_WAIT(); asm volatile("" ::: "memory");
        const v4u z = {0u, 0u, 0u, 0u}; v4u q0; q0.x = 0x3f803f80u; q0.y = 0x00003f80u; q0.z = 0u; q0.w = 0u;
        const int row = pm * 256 + 4 * lane;
        const unsigned ko = hm_off<80, 4>(row, h, 64), qo = (unsigned)(row * 320 + h * 80 + 64);
#pragma unroll
        for (int i = 0; i < 4; ++i) {
            run += lv[i];
            const float v = -run;
            const float b1 = bf2f(f2bf1(v)); const float r1 = v - b1; const float b2 = bf2f(f2bf1(r1)); const float r2 = r1 - b2;
            v4u k0; k0.x = pk2(b1, b2); k0.y = pk2(r2, 0.f); k0.z = 0u; k0.w = 0u;
            *(GAS v4u*)(KF + (ko + i * 80u)) = k0; *(GAS v4u*)(KF + (ko + i * 80u + 8u)) = z;
            *(GAS v4u*)(QF + (qo + i * 320u)) = q0; *(GAS v4u*)(QF + (qo + i * 320u + 8u)) = z;
        }
    }
}

__device__ __forceinline__ void glds16(const void* gsrc, unsigned lds_dst) { unsigned keep;
    asm volatile("s_mov_b32 %0, m0\n\ts_mov_b32 m0, %2\n\ts_nop 0\n\tglobal_load_lds_dwordx4 %1, off\n\ts_mov_b32 m0, %0" : "=&s"(keep) : "v"(gsrc), "s"(lds_dst) : "memory"); }
__device__ __forceinline__ void build_kmf(const float* KMP, bf16* KMF, int gw, int NGW, int lane) {
    const int r32 = lane & 31, hi = lane >> 5;
    for (int t4 = gw; t4 < NB * 4 * 4; t4 += NGW) { const int task = t4 >> 2, d0 = t4 & 3, b = task >> 2, h = task & 3;
        float v[8];
#pragma unroll
        for (int j = 0; j < 8; ++j) { v[j] = 0.f; if (r32 < 8) { const float* p = KMP + ((size_t)(b * 8 + r32) * 2) * 256 + h * 64 + 16 * d0 + 8 * hi + j; v[j] = p[0] + p[256]; } }
        v4u wh, wl; float l[8], hh[8];
#pragma unroll
        for (int j = 0; j < 8; ++j) { hh[j] = bf2f(f2bf1(v[j])); l[j] = v[j] - hh[j]; }
        wh.x = pk2(hh[0], hh[1]); wh.y = pk2(hh[2], hh[3]); wh.z = pk2(hh[4], hh[5]); wh.w = pk2(hh[6], hh[7]);
        wl.x = pk2(l[0], l[1]); wl.y = pk2(l[2], l[3]); wl.z = pk2(l[4], l[5]); wl.w = pk2(l[6], l[7]);
        *(GAS v4u*)(KMF + (((size_t)task * 2 + 0) * 4 + d0) * 512 + lane * 8) = wh;
        *(GAS v4u*)(KMF + (((size_t)task * 2 + 1) * 4 + d0) * 512 + lane * 8) = wl;
    }
}
using pg8::Unit;
template <int HEADPITCH>
__device__ __forceinline__ void store_bf16_tile(const f32x4 (&acc)[2][2][4][2], bf16* base, int pitch, int row0, int ct0, float sc) {
#pragma unroll
    for (int ai = 0; ai < 2; ++ai)
#pragma unroll
        for (int m = 0; m < 4; ++m) { bf16* rowp = base + (size_t)(row0 + ai * 128 + m * 16) * pitch;
#pragma unroll
            for (int bj = 0; bj < 2; ++bj) { const int ct = bj * 128 + ct0; const int col = HEADPITCH ? (ct >> 6) * HEADPITCH + (ct & 63) : ct;
                *(GAS v4u*)(rowp + col) = pack8(acc[ai][bj][m][0] * sc, acc[ai][bj][m][1] * sc); } }
}
struct EpiInproj {
    static constexpr bool PERM = true, AFTER_DRAIN = false, KSCALE = false;
    unsigned char* ws; const float* bfg;
    __device__ __forceinline__ void operator()(const f32x4 (&acc)[2][2][4][2], const Unit& u, int wr, int wc, int fr, int fq) const {
        unsigned char* wsl = ws; asm volatile("" : "+s"(wsl));
        bf16* const QF = (bf16*)ws_at(wsl, WS_QF); bf16* const KF = (bf16*)ws_at(wsl, WS_KF); bf16* const VF = (bf16*)ws_at(wsl, WS_VF); bf16* const QM = (bf16*)ws_at(wsl, WS_QM); bf16* const KM = (bf16*)ws_at(wsl, WS_KM);
        bf16* const VM = (bf16*)ws_at(wsl, WS_VM); bf16* const CQ = (bf16*)ws_at(wsl, WS_CQ); bf16* const T7 = (bf16*)ws_at(wsl, WS_T7); bf16* const KR = (bf16*)ws_at(wsl, WS_KR);
        float* const KMP = (float*)ws_at(wsl, WS_KMP); float* const CQSS = (float*)ws_at(wsl, WS_CQSS); float* const CKVSS = (float*)ws_at(wsl, WS_CKVSS); float* const LOGF = (float*)ws_at(wsl, WS_LOGF);
        const f32x2* const ROPE = (const f32x2*)ws_at(wsl, WS_ROPE);
        const int row0 = u.pm * 256 + wr * 64 + fr, ct0 = wc * 32 + 8 * fq;
        const int pn = u.pn;
        if (pn == 0) { store_bf16_tile<80>(acc, QF, 320, row0, ct0, C2_64); return; }
        if (pn == 1) {
            const int hd0 = ct0 >> 6, d = ct0 & 63;
#pragma unroll
            for (int ai = 0; ai < 2; ++ai)
#pragma unroll
                for (int m = 0; m < 4; ++m) { const unsigned off = hm_off<80, 4>(row0 + ai * 128 + m * 16, hd0, d);
                    *(GAS v4u*)(KF + off) = pack8(acc[ai][0][m][0], acc[ai][0][m][1]); *(GAS v4u*)(KF + (off + 2u * SEQ * 80u)) = pack8(acc[ai][1][m][0], acc[ai][1][m][1]);
                    if (m & 1) asm volatile("" ::: "memory"); }
            return; }
        if (pn == 2) { store_bf16_tile<0>(acc, VF, 256, row0, ct0, 1.f); return; }
        if (pn == 3) { store_bf16_tile<0>(acc, QM, 256, row0, ct0, C2_64); return; }
        if (pn == 5) { store_bf16_tile<0>(acc, VM, 256, row0, ct0, 1.f); return; }
        if (pn == 4) {
            store_bf16_tile<0>(acc, KM, 256, row0, ct0, 1.f);
#pragma unroll
            for (int bj = 0; bj < 2; ++bj)
#pragma unroll
                for (int n = 0; n < 2; ++n) { f32x4 s = {0.f, 0.f, 0.f, 0.f};
#pragma unroll
                    for (int ai = 0; ai < 2; ++ai)
#pragma unroll
                        for (int m = 0; m < 4; ++m) s += acc[ai][bj][m][n];
                    s.x = sum16(s.x); s.y = sum16(s.y); s.z = sum16(s.z); s.w = sum16(s.w);
                    if (fr == 0) *(GAS f32x4*)(KMP + ((size_t)u.pm * 2 + wr) * 256 + bj * 128 + ct0 + 4 * n) = s; }
            return;
        }
        if (pn == 6) {
            store_bf16_tile<0>(acc, CQ, 256, row0, ct0, 1.f);
#pragma unroll
            for (int ai = 0; ai < 2; ++ai)
#pragma unroll
                for (int m = 0; m < 4; ++m) { float s = 0.f;
#pragma unroll
                    for (int bj = 0; bj < 2; ++bj)
#pragma unroll
                        for (int n = 0; n < 2; ++n) { const f32x4 x = acc[ai][bj][m][n]; s += (x.x * x.x + x.y * x.y) + (x.z * x.z + x.w * x.w); }
                    s = sum_rows(s);
                    if (fq == 0) CQSS[(size_t)(row0 + ai * 128 + m * 16) * 4 + wc] = s; }
            return;
        }
#pragma unroll
        for (int ai = 0; ai < 2; ++ai)
#pragma unroll
            for (int m = 0; m < 4; ++m) *(GAS v4u*)(T7 + (unsigned)((row0 + ai * 128 + m * 16) * 128 + ct0)) = pack8(acc[ai][0][m][0], acc[ai][0][m][1]);
        f32x4 fsum = {0.f, 0.f, 0.f, 0.f};
#pragma unroll
        for (int ai = 0; ai < 2; ++ai)
#pragma unroll
            for (int m = 0; m < 4; ++m) { const int row = row0 + ai * 128 + m * 16; float s = 0.f;
#pragma unroll
                for (int n = 0; n < 2; ++n) { const f32x4 x = acc[ai][0][m][n]; s += (x.x * x.x + x.y * x.y) + (x.z * x.z + x.w * x.w); }
                s = sum_rows(s);
                if (fq == 0) CKVSS[(size_t)row * 4 + wc] = s;
                if (wc == 0) {
                    const int pos = row & (SEQ - 1); f32x4 o[2];
#pragma unroll
                    for (int n = 0; n < 2; ++n) { const f32x4 x = acc[ai][1][m][n]; f32x4 p;
                        p.x = other_half(x.x, fq >> 1); p.y = other_half(x.y, fq >> 1); p.z = other_half(x.z, fq >> 1); p.w = other_half(x.w, fq >> 1);
                        const int d = 8 * fq + 4 * n; const float sg = (fq < 2) ? -1.f : 1.f;
                        const GAS f32x2* cs = (const GAS f32x2*)ROPE + pos * 16 + (d & 15);
                        const f32x2 c0 = cs[0], c1 = cs[1], c2 = cs[2], c3 = cs[3];
                        o[n].x = x.x * c0.x + sg * p.x * c0.y; o[n].y = x.y * c1.x + sg * p.y * c1.y; o[n].z = x.z * c2.x + sg * p.z * c2.y; o[n].w = x.w * c3.x + sg * p.w * c3.y; }
                    const v4u w = pack8(o[0], o[1]);
                    *(GAS v4u*)(KR + (unsigned)(row * 32 + 8 * fq)) = w;
                }
                if (wc == 1 && fq == 0) {
                    const f32x4 x = acc[ai][1][m][0]; f32x4 r;
#pragma unroll
                    for (int j = 0; j < 4; ++j) { const float z = x[j] + bfg[j]; const float az = __builtin_fabsf(z);
                        r[j] = __builtin_fminf(z, 0.f) * LOG2E - __builtin_amdgcn_logf(1.f + __builtin_amdgcn_exp2f(-az * LOG2E)); }
                    *(GAS f32x4*)(LOGF + (size_t)row * 4) = r; fsum += r;
                }
            }
        if (wc == 1) { fsum.x = sum16(fsum.x); fsum.y = sum16(fsum.y); fsum.z = sum16(fsum.z); fsum.w = sum16(fsum.w);
            if (fq == 0 && fr == 0) *(GAS f32x4*)((float*)ws_at(wsl, WS_PSUM) + ((size_t)u.pm * 2 + wr) * 4) = fsum; }
    }
};
struct EpiQup {
    static constexpr bool PERM = true, AFTER_DRAIN = false, KSCALE = false;
    bf16* QC; const float* CQSS; const f32x2* ROPE;
    __device__ __forceinline__ void operator()(const f32x4 (&acc)[2][2][4][2], const Unit& u, int wr, int wc, int fr, int fq) const {
        const int row0 = u.pm * 256 + wr * 64 + fr;
        f32x4 ss[2][4]; float rstd[2][4];
#pragma unroll
        for (int ai = 0; ai < 2; ++ai)
#pragma unroll
            for (int m = 0; m < 4; ++m) ss[ai][m] = *(const GAS f32x4*)(CQSS + (size_t)(row0 + ai * 128 + m * 16) * 4);
#pragma unroll
        for (int ai = 0; ai < 2; ++ai)
#pragma unroll
            for (int m = 0; m < 4; ++m) rstd[ai][m] = fast_rsqrt(((ss[ai][m].x + ss[ai][m].y) + (ss[ai][m].z + ss[ai][m].w)) * (1.f / 256.f) + RMS_EPS);
        const int rbj = ((8 * u.pn + wc) % 3 == 2) ? 0 : (((8 * u.pn + 4 + wc) % 3 == 2) ? 1 : -1);
        const float sg = (fq < 2) ? -1.f : 1.f;
#pragma unroll
        for (int ai = 0; ai < 2; ++ai)
#pragma unroll
            for (int mp = 0; mp < 4; mp += 2) {
                f32x4 cs[2][4];
                if (rbj >= 0) {
#pragma unroll
                    for (int m2 = 0; m2 < 2; ++m2) { const int pos = (row0 + ai * 128 + (mp + m2) * 16) & (SEQ - 1); const GAS f32x4* cp = (const GAS f32x4*)((const GAS f32x2*)ROPE + pos * 16 + 8 * (fq & 1));
#pragma unroll
                        for (int q = 0; q < 4; ++q) cs[m2][q] = cp[q]; }
                }
#pragma unroll
                for (int m2 = 0; m2 < 2; ++m2) { const int m = mp + m2; const int row = row0 + ai * 128 + m * 16; const float rs = rstd[ai][m];
#pragma unroll
                    for (int bj = 0; bj < 2; ++bj) { f32x4 o[2];
#pragma unroll
                        for (int n = 0; n < 2; ++n) { const f32x4 x = acc[ai][bj][m][n] * rs;
                            if (bj == rbj) { f32x4 p; p.x = other_half(x.x, fq >> 1); p.y = other_half(x.y, fq >> 1); p.z = other_half(x.z, fq >> 1); p.w = other_half(x.w, fq >> 1);
                                const f32x4 c01 = cs[m2][2 * n], c23 = cs[m2][2 * n + 1];
                                o[n].x = x.x * c01.x + sg * p.x * c01.y; o[n].y = x.y * c01.z + sg * p.y * c01.w; o[n].z = x.z * c23.x + sg * p.z * c23.y; o[n].w = x.w * c23.z + sg * p.w * c23.w;
                            } else o[n] = x; }
                        *(GAS v4u*)(QC + (size_t)row * 768 + u.pn * 256 + bj * 128 + wc * 32 + 8 * fq) = pack8(o[0] * C2_96, o[1] * C2_96); } }
                asm volatile("" ::: "memory");
            }
    }
};
struct EpiKVup {
    static constexpr bool PERM = true, AFTER_DRAIN = false, KSCALE = false;
    bf16 *KC, *VC; const float* CKVSS;
    __device__ __forceinline__ void operator()(const f32x4 (&acc)[2][2][4][2], const Unit& u, int wr, int wc, int fr, int fq) const {
        const int row0 = u.pm * 256 + wr * 64 + fr;
        f32x4 ss[2][4]; float rstd[2][4];
#pragma unroll
        for (int ai = 0; ai < 2; ++ai)
#pragma unroll
            for (int m = 0; m < 4; ++m) ss[ai][m] = *(const GAS f32x4*)(CKVSS + (size_t)(row0 + ai * 128 + m * 16) * 4);
#pragma unroll
        for (int ai = 0; ai < 2; ++ai)
#pragma unroll
            for (int m = 0; m < 4; ++m) rstd[ai][m] = fast_rsqrt(((ss[ai][m].x + ss[ai][m].y) + (ss[ai][m].z + ss[ai][m].w)) * (1.f / 128.f) + RMS_EPS);
#pragma unroll
        for (int ai = 0; ai < 2; ++ai)
#pragma unroll
            for (int m = 0; m < 4; ++m) { const int row = row0 + ai * 128 + m * 16; const float rs = rstd[ai][m];
#pragma unroll
                for (int bj = 0; bj < 2; ++bj) { const int head = 2 * u.pn + bj, within = wc * 32 + 8 * fq;
                    const v4u w = pack8(acc[ai][bj][m][0] * rs, acc[ai][bj][m][1] * rs);
                    if (wc < 2) *(GAS v4u*)(KC + hm_off<64, 8>(row, head, within)) = w;
                    else *(GAS v4u*)(VC + (size_t)row * 512 + head * 64 + (within - 64)) = w; } }
    }
};
struct EpiY {
    static constexpr bool PERM = true, AFTER_DRAIN = false, KSCALE = false;
    bf16* Y; float* YSS;
    __device__ __forceinline__ void operator()(const f32x4 (&acc)[2][2][4][2], const Unit& u, int wr, int wc, int fr, int fq) const {
        asm volatile("" : "+v"(fr), "+v"(fq));
        const int row0 = u.pm * 256 + wr * 64 + fr, ct0 = wc * 32 + 8 * fq;
#pragma unroll
        for (int ai = 0; ai < 2; ++ai)
#pragma unroll
            for (int m = 0; m < 4; ++m) { const int row = row0 + ai * 128 + m * 16; float s = 0.f;
#pragma unroll
                for (int bj = 0; bj < 2; ++bj) {
#pragma unroll
                    for (int n = 0; n < 2; ++n) { const f32x4 x = acc[ai][bj][m][n]; s += (x.x * x.x + x.y * x.y) + (x.z * x.z + x.w * x.w); }
                    *(GAS v4u*)(Y + (unsigned)(row * DM + u.pn * 256 + bj * 128 + ct0)) = pack8(acc[ai][bj][m][0], acc[ai][bj][m][1]); }
                s = sum_rows(s);
                if (fq == 0) YSS[(unsigned)(row * 16 + u.pn * 4 + wc)] = s; }
    }
};
struct EpiYks {
    static constexpr bool PERM = true, AFTER_DRAIN = false, KSCALE = true;
    bf16* Y; float* YSS; const float* F; LAS float* tab;
    __device__ __forceinline__ void prep(const Unit& u, int par, int wid, int lane) const {
        if (wid < 4) glds16(F + ((size_t)u.pm * 256 + wid * 64 + lane) * 4, (unsigned)__builtin_amdgcn_readfirstlane((unsigned)(uintptr_t)tab + par * 4096 + wid * 1024)); }
    __device__ __forceinline__ void kscale(f32x4 (&acc)[2][2][4][2], int par, int which, int wr, int fr) const {
#pragma unroll
        for (int ai = 0; ai < 2; ++ai)
#pragma unroll
            for (int m = 0; m < 4; ++m) { const float s = tab[par * 1024 + (ai * 128 + wr * 64 + m * 16 + fr) * 4 + which];
#pragma unroll
                for (int bj = 0; bj < 2; ++bj)
#pragma unroll
                    for (int n = 0; n < 2; ++n) acc[ai][bj][m][n] *= s; } }
    __device__ __forceinline__ void operator()(const f32x4 (&acc)[2][2][4][2], const Unit& u, int wr, int wc, int fr, int fq) const {
        const int row0 = u.pm * 256 + wr * 64 + fr, ct0 = wc * 32 + 8 * fq;
#pragma unroll
        for (int ai = 0; ai < 2; ++ai)
#pragma unroll
            for (int m = 0; m < 4; ++m) { const int row = row0 + ai * 128 + m * 16; float s = 0.f;
#pragma unroll
                for (int bj = 0; bj < 2; ++bj) {
#pragma unroll
                    for (int n = 0; n < 2; ++n) { const f32x4 x = acc[ai][bj][m][n]; s += (x.x * x.x + x.y * x.y) + (x.z * x.z + x.w * x.w); }
                    *(GAS v4u*)(Y + (size_t)row * DM + u.pn * 256 + bj * 128 + ct0) = pack8(acc[ai][bj][m][0], acc[ai][bj][m][1]); }
                s = sum_rows(s);
                if (fq == 0) YSS[(size_t)row * 16 + u.pn * 4 + wc] = s; }
    }
};
struct EpiSwiglu {
    static constexpr bool PERM = true, AFTER_DRAIN = false, KSCALE = false;
    bf16* ACT; unsigned char* ACT8; int pm8;
    __device__ __forceinline__ void operator()(const f32x4 (&acc)[2][2][4][2], const Unit& u, int wr, int wc, int fr, int fq) const {
        const int row0 = u.pm * 256 + wr * 64 + fr, ct0 = wc * 32 + 8 * fq; const bool f8 = (PM8_L0 == 256 && PM8_L1 == 256) || u.pm < pm8;
#pragma unroll
        for (int ai = 0; ai < 2; ++ai)
#pragma unroll
            for (int m = 0; m < 4; ++m) { const int row = row0 + ai * 128 + m * 16; f32x4 o[2];
#pragma unroll
                for (int n = 0; n < 2; ++n) { const f32x4 g = acc[ai][0][m][n], up = acc[ai][1][m][n];
#pragma unroll
                    for (int j = 0; j < 4; ++j) o[n][j] = g[j] * up[j] * __builtin_amdgcn_rcpf(1.f + __builtin_amdgcn_exp2f(g[j])); }
                if (f8) { u32x2 w; { int t = __builtin_amdgcn_cvt_pk_fp8_f32(o[0][0], o[0][1], 0, false); t = __builtin_amdgcn_cvt_pk_fp8_f32(o[0][2], o[0][3], t, true); w.x = (unsigned)t; }
                    { int t = __builtin_amdgcn_cvt_pk_fp8_f32(o[1][0], o[1][1], 0, false); t = __builtin_amdgcn_cvt_pk_fp8_f32(o[1][2], o[1][3], t, true); w.y = (unsigned)t; }
                    *(GAS u32x2*)(ACT8 + (size_t)row * DFF + u.pn * 128 + ct0) = w; }
                else __builtin_nontemporal_store(pack8(o[0], o[1]), (GAS v4u*)(ACT + (size_t)row * DFF + u.pn * 128 + ct0)); }
    }
};

__device__ __forceinline__ int crow(int r, int hi) { return (r & 3) + 8 * (r >> 2) + 4 * hi; }
typedef short v4i16_t __attribute__((ext_vector_type(4)));
__device__ __forceinline__ float half_max(float m) { auto rr = __builtin_amdgcn_permlane32_swap(__float_as_uint(m), __float_as_uint(m), false, false); return __builtin_fmaxf(__uint_as_float(rr[0]), __uint_as_float(rr[1])); }
__device__ __forceinline__ float half_sum(float m) { auto rr = __builtin_amdgcn_permlane32_swap(__float_as_uint(m), __float_as_uint(m), false, false); return __uint_as_float(rr[0]) + __uint_as_float(rr[1]); }
namespace att {
__device__ __forceinline__ void glds16s(unsigned voff, const void* sbase, unsigned lds_dst) { unsigned keep;
    asm volatile("s_mov_b32 %0, m0\n\ts_mov_b32 m0, %2\n\ts_nop 0\n\tglobal_load_lds_dwordx4 %1, %3\n\ts_mov_b32 m0, %0" : "=&s"(keep) : "v"(voff), "s"(lds_dst), "s"(sbase) : "memory"); }
template <class T> __device__ __forceinline__ T* uniform_ptr(T* p) { const unsigned long long v = (unsigned long long)p;
    const unsigned lo = (unsigned)__builtin_amdgcn_readfirstlane((int)(unsigned)v), hi = (unsigned)__builtin_amdgcn_readfirstlane((int)(unsigned)(v >> 32)); return (T*)(((unsigned long long)hi << 32) | lo); }
typedef short s16x4 __attribute__((ext_vector_type(4)));
typedef unsigned u32x4_t __attribute__((ext_vector_type(4)));
typedef __attribute__((address_space(3))) const char* lds_cptr;
#define SBAR() __builtin_amdgcn_sched_barrier(0)
__device__ __forceinline__ float max3f(float a, float b, float c) { float r; asm("v_max3_f32 %0, %1, %2, %3" : "=v"(r) : "v"(a), "v"(b), "v"(c)); return r; }
__device__ __forceinline__ float max2f(float a, float b) { float r; asm("v_max_f32_e32 %0, %1, %2" : "=v"(r) : "v"(a), "v"(b)); return r; }
__device__ __forceinline__ float fadd_s(float a, float b) { float r; asm("v_add_f32_e32 %0, %1, %2" : "=v"(r) : "v"(a), "v"(b)); return r; }
__device__ __forceinline__ float fsub_s(float a, float b) { float r; asm("v_sub_f32_e32 %0, %1, %2" : "=v"(r) : "v"(a), "v"(b)); return r; }
#define WAIT_BAR(N) asm volatile("s_waitcnt vmcnt(" #N ") lgkmcnt(0)\n\ts_barrier" ::: "memory")
#define WB_K2V1() do { if (k2) WAIT_BAR(5); else WAIT_BAR(3); } while (0)
#define WB_K1V1() do { if (k2) WAIT_BAR(3); else WAIT_BAR(2); } while (0)
#define WB_K1V2() do { if (k2) WAIT_BAR(4); else WAIT_BAR(3); } while (0)
#define WB_K2V2() do { if (k2) WAIT_BAR(6); else WAIT_BAR(4); } while (0)
#define WB_K0V1() WAIT_BAR(1)
#define WB_0() WAIT_BAR(0)
__device__ __forceinline__ void cmask(f32x16& p0, f32x16& p1, int jb, int qrel, int hi) {
    const float NEG = -INFINITY; const int kb = 64 * jb + 4 * hi;
#pragma unroll
    for (int r = 0; r < 16; ++r) { const int kv = kb + (r & 3) + 8 * (r >> 2); if (kv > qrel) p0[r] = NEG; if (kv + 32 > qrel) p1[r] = NEG; }
}
template <int KD>
__device__ __forceinline__ void qkt(f32x16& p0, f32x16& p1, lds_cptr kb, const bf16x8* qr, const f32x16& negm) {
#pragma unroll
    for (int d0 = 0; d0 < KD; ++d0) {
        const bf16x8 b0 = *(const LAS bf16x8*)(kb + d0 * 2048);
        const bf16x8 b1 = *(const LAS bf16x8*)(kb + d0 * 2048 + 512);
        if (d0 == 0) { p0 = __builtin_amdgcn_mfma_f32_32x32x16_bf16(b0, qr[0], negm, 0, 0, 0); p1 = __builtin_amdgcn_mfma_f32_32x32x16_bf16(b1, qr[0], negm, 0, 0, 0); }
        else { p0 = __builtin_amdgcn_mfma_f32_32x32x16_bf16(b0, qr[d0], p0, 0, 0, 0); p1 = __builtin_amdgcn_mfma_f32_32x32x16_bf16(b1, qr[d0], p1, 0, 0, 0); } }
}
__device__ __forceinline__ void kload2(bf16x8* kf, lds_cptr kp, int j) { kf[2 * j] = *(const LAS bf16x8*)(kp + j * 2048); kf[2 * j + 1] = *(const LAS bf16x8*)(kp + j * 2048 + 512); }
__device__ __forceinline__ s16x4 vtr(lds_cptr p) { return __builtin_bit_cast(s16x4, __builtin_amdgcn_ds_read_tr16_b64_v4i16((LAS v4i16_t*)p)); }
__device__ __forceinline__ float rowmax(const f32x16& p0, const f32x16& p1) {
    float a = max3f(p0[0], p0[1], p1[0]), b = max3f(p0[2], p0[3], p1[1]); a = max3f(a, p1[2], p1[3]);
#pragma unroll
    for (int r = 4; r < 16; r += 4) { a = max3f(a, p0[r], p0[r + 1]); b = max3f(b, p0[r + 2], p0[r + 3]); a = max3f(a, p1[r], p1[r + 1]); b = max3f(b, p1[r + 2], p1[r + 3]); }
    const float m = max2f(a, b);
    auto rr = __builtin_amdgcn_permlane32_swap(__float_as_uint(m), __float_as_uint(m), false, false);
    return max2f(__uint_as_float(rr[0]), __uint_as_float(rr[1]));
}
__device__ __forceinline__ void pv(f32x16* o, int vb, bf16x8 pa0, bf16x8 pa1, bf16x8 pa2, bf16x8 pa3) {
#pragma unroll
    for (int d0 = 0; d0 < 2; ++d0) { s16x4 lo[4], hi[4];
#pragma unroll
        for (int ks = 0; ks < 4; ++ks) {
            asm volatile("ds_read_b64_tr_b16 %0,%1 offset:%c2" : "=&v"(lo[ks]) : "v"(vb), "i"(d0 * 4096 + ks * 1024) : "memory");
            asm volatile("ds_read_b64_tr_b16 %0,%1 offset:%c2" : "=&v"(hi[ks]) : "v"(vb), "i"(d0 * 4096 + ks * 1024 + 512) : "memory"); }
        asm volatile("s_waitcnt lgkmcnt(0)" ::: "memory"); SBAR();
#define PK(k) (bf16x8){lo[k][0], lo[k][1], lo[k][2], lo[k][3], hi[k][0], hi[k][1], hi[k][2], hi[k][3]}
        o[d0] = __builtin_amdgcn_mfma_f32_32x32x16_bf16(pa0, PK(0), o[d0], 0, 0, 0);
        o[d0] = __builtin_amdgcn_mfma_f32_32x32x16_bf16(pa1, PK(1), o[d0], 0, 0, 0);
        o[d0] = __builtin_amdgcn_mfma_f32_32x32x16_bf16(pa2, PK(2), o[d0], 0, 0, 0);
        o[d0] = __builtin_amdgcn_mfma_f32_32x32x16_bf16(pa3, PK(3), o[d0], 0, 0, 0);
#undef PK
    }
}
template <int KD> struct Lay { static constexpr int KSLOT = KD * 2048, VSLOT = 8192, LDS_K = 0, LDS_V = 3 * KSLOT, LDS_WS = LDS_V + 4 * VSLOT, LDS_TB = LDS_WS + 2048, LDS_OST = LDS_TB + 1024, LDS_END = LDS_OST + 8 * 4096; };

template <int KD, int MODE, int THRL, int KBS  , int KPITCH>
__device__ __forceinline__ void attn_unit_t(const bf16* Q, int qpitch, const bf16* __restrict__ K, const bf16* __restrict__ V, int vpitch, bf16* O,
                                            int b, int qb, LAS unsigned char* lds, const float* kmp_b, float* oss, bool pre, int nb, int nqb, const bf16* KR = nullptr  ) {
    constexpr int kpitch = KPITCH;
    typedef Lay<KD> LY; constexpr int KSLOT = LY::KSLOT, SLOTB = LY::VSLOT, LDS_K = LY::LDS_K, LDS_V = LY::LDS_V;
    static_assert(LY::LDS_END <= RING_BYTES, "attention LDS map");
    int tid = threadIdx.x; asm volatile("" : "+v"(tid));
    const int lane = tid & 63, r32 = lane & 31, hi = lane >> 5; const int wid = __builtin_amdgcn_readfirstlane(tid >> 6);
    const long rowbase = (long)b * SEQ; const int q0 = qb * 256;
    const bf16* Qw = Q + (rowbase + q0 + wid * 32) * qpitch;
    const bf16* Kh = K + (long)b * KBS, *Vh = V + rowbase * vpitch;
    const unsigned lds0 = (unsigned)(uintptr_t)lds;
    LAS float* wsf = (LAS float*)(lds + LY::LDS_WS) + wid * 64;
    const bool k2 = (wid + 8 < 2 * KD);
    const bf16* ksrc = Kh + (long)lane * kpitch + wid * 8;
    const bf16* vsrc = Vh + (long)(16 * (wid & 3) + (lane >> 2)) * vpitch + (wid >> 2) * 32 + (lane & 3) * 8;
    const unsigned kdst = lds0 + LDS_K + wid * 1024, vdst = lds0 + LDS_V + wid * 1024;
    const bf16* krh = (KD == 6) ? uniform_ptr(KR + rowbase * 32) : nullptr;
#define KO(x) (((x) >> 2) * KD)
#define DMA_K2(kbase_, krb_, t, slot) do { const unsigned kd_ = (unsigned)__builtin_amdgcn_readfirstlane(kdst + KO(slot)); glds16((kbase_) + (long)(t) * 64 * kpitch, kd_); \
        if (k2) { if constexpr (KD == 6) glds16s((unsigned)(lane * 64 + wid * 16) + (unsigned)(t) * 4096u, krb_, kd_ + 8192); else glds16((kbase_) + 64 + (long)(t) * 64 * kpitch, kd_ + 8192); } } while (0)
#define DMA_K(t, slot) DMA_K2(ksrc, krh, t, slot)
#define DMA_V(t, slot) glds16(vsrc + (long)(t) * 64 * vpitch, (unsigned)__builtin_amdgcn_readfirstlane(vdst + (slot)))
    const lds_cptr shm3 = (lds_cptr)lds;
    const lds_cptr kp0 = shm3 + LDS_K + hi * 1024 + r32 * 16;
    const lds_cptr vp0 = shm3 + LDS_V + ((lane >> 4) & 1) * 32 + (lane & 3) * 8 + (4 * hi + ((lane & 15) >> 2)) * 64;
    const int vb0 = (int)(lds0 + LDS_V) + ((lane >> 4) & 1) * 32 + (lane & 3) * 8 + (4 * hi + ((lane & 15) >> 2)) * 64;
    bf16x8 kf[2 * KD];
    const int NT = 4 * (qb + 1);
    if (!pre) { DMA_K(0, 0); DMA_V(0, 0); DMA_K(1, SLOTB); DMA_V(1, SLOTB); }
    bf16x8 qr[KD];
#pragma unroll
    for (int d0 = 0; d0 < KD; ++d0) qr[d0] = *(const GAS bf16x8*)(Qw + (long)r32 * qpitch + d0 * 16 + hi * 8);
    const int qrel = wid * 32 + r32, qpos = q0 + qrel;
    unsigned selmask = 0xffu;
    if (MODE == 1 && qb >= 4) {
        const bf16* kmf = (const bf16*)kmp_b; f32x16 ga = f32x16{};
#pragma unroll
        for (int hl = 0; hl < 2; ++hl)
#pragma unroll
            for (int d0 = 0; d0 < 4; ++d0) { const bf16x8 a = *(const GAS bf16x8*)(kmf + ((hl * 4 + d0) * 64 + lane) * 8); ga = __builtin_amdgcn_mfma_f32_32x32x16_bf16(a, qr[d0], ga, 0, 0, 0); }
        float g[8];
#pragma unroll
        for (int j = 0; j < 4; ++j) { auto rr = __builtin_amdgcn_permlane32_swap(__float_as_uint(ga[j]), __float_as_uint(ga[j]), false, false); g[j] = __uint_as_float(rr[0]); g[4 + j] = __uint_as_float(rr[1]); }
#pragma unroll
        for (int n = 0; n < 7; ++n) if (n >= qb) g[n] = -INFINITY;
        selmask = 0u;
#pragma unroll
        for (int n = 0; n < 7; ++n) { int rank = 0;
#pragma unroll
            for (int mm = 0; mm < 7; ++mm) if (mm != n) rank += (g[mm] > g[n] || (g[mm] == g[n] && mm < n)) ? 1 : 0;
            if (n < qb && rank < 3) selmask |= 1u << n; }
    }
#define SELNEG(blk_) ((MODE != 1 || (blk_) >= qb || ((selmask >> (blk_)) & 1u)) ? 0.f : -INFINITY)
    float selneg = SELNEG(0);
    float mhat = 0.f, l_reg = 0.f; f32x16 o[2]; o[0] = f32x16{}; o[1] = f32x16{}; f32x16 negm;
#pragma unroll
    for (int r = 0; r < 16; ++r) negm[r] = selneg;
    asm volatile("" : "+v"(negm));
    const LAS float* TBl = (const LAS float*)(lds + LY::LDS_TB);
#define TBIAS(P0, P1, t) do { int D0_ = qpos - 64 * (t) - 4 * hi; D0_ = D0_ < -1 ? -1 : (D0_ > 191 ? 191 : D0_); const LAS float* rb_ = TBl + (191 - D0_); \
        _Pragma("unroll") for (int r = 0; r < 16; ++r) { const int c_ = (r & 3) + 8 * (r >> 2); P0[r] += rb_[c_]; P1[r] += rb_[c_ + 32]; } } while (0)
#define CMASK(P0, P1, t) do { if (MODE == 0) { const int jb_ = (t) - (NT - 4); if (jb_ >= 0) cmask(P0, P1, jb_, qrel, hi); } else { if ((t) + 6 >= NT) TBIAS(P0, P1, t); } } while (0)
    bool resc = false;
#define START(P0, P1) do { const float rm = rowmax(P0, P1); resc = false; \
    { const float dl = __builtin_fmaxf(rm, 0.f); mhat = fadd_s(mhat, dl); \
      _Pragma("unroll") for (int r = 0; r < 16; ++r) { P0[r] = fsub_s(P0[r], dl); P1[r] = fsub_s(P1[r], dl); } \
      _Pragma("unroll") for (int r = 0; r < 16; ++r) negm[r] = selneg - mhat; asm volatile("" : "+v"(negm)); } \
    _Pragma("unroll") for (int r = 0; r < 16; ++r) P0[r] = __builtin_amdgcn_exp2f(P0[r]); } while (0)
#define RESC() do { if (resc) { asm volatile("s_waitcnt lgkmcnt(0)" ::: "memory"); \
      _Pragma("unroll") for (int d_ = 0; d_ < 2; ++d_) _Pragma("unroll") for (int r = 0; r < 16; ++r) o[d_][r] *= wsf[crow(r, hi)]; } } while (0)
#define NEXTBLK(t) do { if (MODE == 1 && (((t) + 1) & 3) == 0) { selneg = SELNEG(((t) + 1) >> 2); _Pragma("unroll") for (int r = 0; r < 16; ++r) negm[r] = selneg - mhat; asm volatile("" : "+v"(negm)); } } while (0)
    f32x16 pA0, pA1, pB0, pB1;
    int sl_cur = 0, sl_next = SLOTB;
    int vs_prev = 0, vs_cur = 0, vs_next = SLOTB, vs_nn = 2 * SLOTB;
#define ROT() do { sl_cur = sl_next; sl_next = (sl_next == 2 * SLOTB) ? 0 : sl_next + SLOTB; vs_prev = vs_cur; vs_cur = vs_next; vs_next = vs_nn; vs_nn = (vs_nn == 3 * SLOTB) ? 0 : vs_nn + SLOTB; } while (0)
    if (!pre) DMA_K(2, 2 * SLOTB);
    WB_K2V2();
    qkt<KD>(pA0, pA1, kp0, qr, negm); asm volatile("s_nop 15\n\ts_nop 7" : "+v"(pA0), "+v"(pA1)); CMASK(pA0, pA1, 0);
    START(pA0, pA1);
#pragma unroll
    for (int r = 0; r < 16; ++r) pA1[r] = __builtin_amdgcn_exp2f(pA1[r]);
    NEXTBLK(0);
    WB_0();
    DMA_K(3, 0); DMA_V(2, 2 * SLOTB);
    ROT();
#pragma unroll
    for (int j = 0; j < KD; ++j) kload2(kf, kp0 + KO(sl_cur), j);
    WB_K1V1();
    s16x4 vlo[8], vhi[8]; u32x4_t pw0, pw1, pw2, pw3;
#define PKW(P, B) pk2(P[B], P[B + 1])
#define PAF(k) __builtin_bit_cast(bf16x8, pw##k)
#define VFR(i) (bf16x8){vlo[i][0], vlo[i][1], vlo[i][2], vlo[i][3], vhi[i][0], vhi[i][1], vhi[i][2], vhi[i][3]}
#define PIN(x) asm volatile("" : "+v"(x))
#define MX3(a, b, c) __builtin_fmaxf(__builtin_fmaxf((a), (b)), (c))
#define MF(a, b, c) __builtin_amdgcn_mfma_f32_32x32x16_bf16(a, b, c, 0, 0, 0)
#define GAPA(MFX, A0, A1, A2, A3, W0, W1, PW) do { MFX; sacc += A0; sacc += A1; sacc += A2; sacc += A3; PIN(sacc); W0; W1; PIN(PW); SBAR(); } while (0)
#define EX(v) __builtin_amdgcn_exp2f(v)
#define GAPB(MFX, X, B) do { MFX; X[B] = EX(X[B]); X[B + 1] = EX(X[B + 1]); X[B + 2] = EX(X[B + 2]); X[B + 3] = EX(X[B + 3]); PIN(X); SBAR(); } while (0)
#define VRD(i) do { vlo[i] = vtr(vp_ + (((i) >> 2) * 4096 + ((i) & 3) * 1024)); vhi[i] = vtr(vp_ + (((i) >> 2) * 4096 + ((i) & 3) * 1024 + 512)); } while (0)
#define KRD(G, j) do { if (G) { kload2(kf, kp0 + KO(sl_next), j); SBAR(); } } while (0)
#define STEP(C0, C1, P0, P1, t, GK, GV, GL) do { SBAR(); \
    const lds_cptr vp_ = vp0 + vs_prev; \
    VRD(0); SBAR(); float sacc = (P0[0] + P0[1]); \
    GAPA(C0 = MF(kf[0], qr[0], negm), P0[2], P0[3], P0[4], P0[5],     pw0[0] = PKW(P0, 0), pw0[1] = PKW(P0, 2), pw0); \
    VRD(4); SBAR(); GAPA(C1 = MF(kf[1], qr[0], negm), P0[6], P0[7], P0[8], P0[9],     pw0[2] = PKW(P0, 4), pw0[3] = PKW(P0, 6), pw0); \
    VRD(1); SBAR(); GAPA(C0 = MF(kf[2], qr[1], C0),   P0[10], P0[11], P0[12], P0[13], pw1[0] = PKW(P0, 8), pw1[1] = PKW(P0, 10), pw1); \
    VRD(5); SBAR(); GAPA(C1 = MF(kf[3], qr[1], C1),   P0[14], P0[15], P1[0], P1[1],   pw1[2] = PKW(P0, 12), pw1[3] = PKW(P0, 14), pw1); \
    VRD(2); SBAR(); GAPA(C0 = MF(kf[4], qr[2], C0),   P1[2], P1[3], P1[4], P1[5],     pw2[0] = PKW(P1, 0), pw2[1] = PKW(P1, 2), pw2); \
    VRD(6); SBAR(); GAPA(C1 = MF(kf[5], qr[2], C1),   P1[6], P1[7], P1[8], P1[9],     pw2[2] = PKW(P1, 4), pw2[3] = PKW(P1, 6), pw2); \
    VRD(3); SBAR(); GAPA(C0 = MF(kf[6], qr[3], C0),   P1[10], P1[11], P1[12], P1[13], pw3[0] = PKW(P1, 8), pw3[1] = PKW(P1, 10), pw3); \
    VRD(7); SBAR(); GAPA(C1 = MF(kf[7], qr[3], C1),   P1[14], P1[15], 0.f, 0.f,       pw3[2] = PKW(P1, 12), pw3[3] = PKW(P1, 14), pw3); \
    if constexpr (KD > 4) { C0 = MF(kf[8], qr[4], C0); SBAR(); C1 = MF(kf[9], qr[4], C1); SBAR(); } \
    if constexpr (KD > 5) { C0 = MF(kf[2 * KD - 2], qr[KD - 1], C0); SBAR(); C1 = MF(kf[2 * KD - 1], qr[KD - 1], C1); SBAR(); } \
    l_reg += sacc; \
    if (GK) { DMA_K((t) + 3, sl_cur); } if (GV) { DMA_V((t) + 2, vs_nn); } \
    CMASK(C0, C1, t); \
    { float a = MX3(C0[0], C0[1], C1[0]), b_ = MX3(C0[2], C0[3], C1[1]); a = MX3(a, C1[2], C1[3]); \
      _Pragma("unroll") for (int r = 4; r < 16; r += 4) { a = MX3(a, C0[r], C0[r + 1]); b_ = MX3(b_, C0[r + 2], C0[r + 3]); a = MX3(a, C1[r], C1[r + 1]); b_ = MX3(b_, C1[r + 2], C1[r + 3]); } \
      float rm = __builtin_fmaxf(a, b_); { auto rr = __builtin_amdgcn_permlane32_swap(__float_as_uint(rm), __float_as_uint(rm), false, false); rm = __builtin_fmaxf(__uint_as_float(rr[0]), __uint_as_float(rr[1])); } \
      resc = false; \
      if (__builtin_expect(__any(rm > (float)THRL), 0)) { const float dl = __builtin_fmaxf(rm, 0.f); mhat += dl; \
        _Pragma("unroll") for (int r = 0; r < 16; ++r) { C0[r] -= dl; C1[r] -= dl; } \
        _Pragma("unroll") for (int r = 0; r < 16; ++r) negm[r] = selneg - mhat; asm volatile("" : "+v"(negm)); \
        const float f = __builtin_amdgcn_exp2f(-dl); l_reg *= f; if (hi == 0) wsf[r32] = f; resc = true; } } \
    SBAR(); \
    GAPB(o[0] = MF(PAF(0), VFR(0), o[0]), C0, 0); \
    GAPB(o[1] = MF(PAF(0), VFR(4), o[1]), C0, 4); \
    KRD(GL, 0); GAPB(o[0] = MF(PAF(1), VFR(1), o[0]), C0, 8); \
    KRD(GL, 1); GAPB(o[1] = MF(PAF(1), VFR(5), o[1]), C0, 12); \
    KRD(GL, 2); GAPB(o[0] = MF(PAF(2), VFR(2), o[0]), C1, 0); \
    KRD(GL, 3); GAPB(o[1] = MF(PAF(2), VFR(6), o[1]), C1, 4); \
    if constexpr (KD > 4) KRD(GL, 4); GAPB(o[0] = MF(PAF(3), VFR(3), o[0]), C1, 8); \
    if constexpr (KD > 5) KRD(GL, 5); GAPB(o[1] = MF(PAF(3), VFR(7), o[1]), C1, 12); \
    NEXTBLK(t); \
    } while (0)
    int t = 1;
#define CMASK_FULL(P0, P1, t) do { if (MODE == 0) { const int jb_ = (t) - (NT - 4); if (jb_ >= 0) cmask(P0, P1, jb_, qrel, hi); } else { if ((t) + 6 >= NT) TBIAS(P0, P1, t); } } while (0)
#undef CMASK
#define CMASK(P0, P1, t) do { } while (0)
    for (; t + 7 < NT; t += 2) {
        STEP(pB0, pB1, pA0, pA1, t, true, true, true);     WB_K1V2(); RESC(); ROT();
        STEP(pA0, pA1, pB0, pB1, t + 1, true, true, true); WB_K1V2(); RESC(); ROT();
    }
#undef CMASK
#define CMASK(P0, P1, t) CMASK_FULL(P0, P1, t)
#define ENDW(tt) do { if ((tt) + 3 < NT) { WB_K1V2(); } else if ((tt) + 2 < NT) { WAIT_BAR(2); } else { WB_0(); } } while (0)
    for (; t + 1 < NT; t += 2) {
        STEP(pB0, pB1, pA0, pA1, t, (t + 3 < NT), (t + 2 < NT), (t + 1 < NT));         ENDW(t);     RESC(); ROT();
        STEP(pA0, pA1, pB0, pB1, t + 1, (t + 4 < NT), (t + 3 < NT), (t + 2 < NT));     ENDW(t + 1); RESC(); ROT();
    }
    if (nqb >= 0) {
        const long nd_ = (long)(nb - b) * SEQ; const bf16* ksn_ = ksrc + (long)(nb - b) * KBS; const bf16* vsn_ = vsrc + nd_ * vpitch; const bf16* krn_ = (KD == 6) ? uniform_ptr(KR + (long)nb * SEQ * 32) : nullptr; (void)krn_;
#define DMA_KN(t, slot) DMA_K2(ksn_, krn_, t, slot)
#define DMA_VN(t, slot) glds16(vsn_ + (long)(t) * 64 * vpitch, (unsigned)__builtin_amdgcn_readfirstlane(vdst + (slot)))
        DMA_KN(0, 0); DMA_VN(0, 0); DMA_KN(1, SLOTB); DMA_VN(1, SLOTB); DMA_KN(2, 2 * SLOTB);
#undef DMA_KN
#undef DMA_VN
    }
    STEP(pB0, pB1, pA0, pA1, NT - 1, false, false, false); RESC();
    { float sacc = pB0[0] + pB0[1];
#pragma unroll
      for (int r = 2; r < 16; ++r) sacc += pB0[r];
#pragma unroll
      for (int r = 0; r < 16; ++r) sacc += pB1[r];
      l_reg += sacc;
      pw0 = (u32x4_t){PKW(pB0, 0), PKW(pB0, 2), PKW(pB0, 4), PKW(pB0, 6)}; pw1 = (u32x4_t){PKW(pB0, 8), PKW(pB0, 10), PKW(pB0, 12), PKW(pB0, 14)};
      pw2 = (u32x4_t){PKW(pB1, 0), PKW(pB1, 2), PKW(pB1, 4), PKW(pB1, 6)}; pw3 = (u32x4_t){PKW(pB1, 8), PKW(pB1, 10), PKW(pB1, 12), PKW(pB1, 14)};
      SBAR(); pv(o, vb0 + vs_cur, PAF(0), PAF(1), PAF(2), PAF(3)); }
    l_reg = half_sum(l_reg);
    if (hi == 0) wsf[32 + r32] = l_reg; asm volatile("s_waitcnt lgkmcnt(0)" ::: "memory");
    float rli[16];
#pragma unroll
    for (int r = 0; r < 16; ++r) rli[r] = __builtin_amdgcn_rcpf(wsf[32 + crow(r, hi)]);
    bf16* Ow = O + (rowbase + q0 + wid * 32) * DM;
    { LAS unsigned short* stg = (LAS unsigned short*)(lds + LY::LDS_OST) + wid * 2048;
#pragma unroll
      for (int r = 0; r < 16; ++r) { const int orow = crow(r, hi);
#pragma unroll
          for (int d0 = 0; d0 < 2; ++d0) stg[orow * 64 + d0 * 32 + r32] = f2bf1(o[d0][r] * rli[r]); }
      asm volatile("s_waitcnt lgkmcnt(0)" ::: "memory");
#pragma unroll
      for (int i = 0; i < 4; ++i) { const int row = i * 8 + (lane >> 3), ch = lane & 7; const v4u v = *(const LAS v4u*)(stg + row * 64 + ch * 8); *(GAS v4u*)(Ow + (long)row * DM + ch * 8) = v;
          float ss; { const float a0 = __uint_as_float(v.x << 16), a1 = __uint_as_float(v.x & 0xffff0000u), a2 = __uint_as_float(v.y << 16), a3 = __uint_as_float(v.y & 0xffff0000u);
              const float a4 = __uint_as_float(v.z << 16), a5 = __uint_as_float(v.z & 0xffff0000u), a6 = __uint_as_float(v.w << 16), a7 = __uint_as_float(v.w & 0xffff0000u);
              ss = ((a0 * a0 + a1 * a1) + (a2 * a2 + a3 * a3)) + ((a4 * a4 + a5 * a5) + (a6 * a6 + a7 * a7)); }
          ss = sum8(ss);
          if (ch == 0) oss[(rowbase + q0 + 32 * wid + row) * 16] = ss; } }
    if (nqb >= 0) asm volatile("s_waitcnt lgkmcnt(0)\n\ts_barrier" ::: "memory");
    else asm volatile("s_waitcnt vmcnt(0) lgkmcnt(0)\n\ts_barrier" ::: "memory");
#undef KO
#undef DMA_K
#undef DMA_K2
#undef DMA_V
#undef SELNEG
#undef TBIAS
#undef CMASK
#undef CMASK_FULL
#undef START
#undef RESC
#undef NEXTBLK
#undef ROT
#undef PKW
#undef PAF
#undef VFR
#undef PIN
#undef MX3
#undef MF
#undef GAPA
#undef EX
#undef GAPB
#undef VRD
#undef KRD
#undef STEP
#undef ENDW
}
#undef SBAR
#undef WAIT_BAR
}
#define ATTN_TB att::Lay<4>::LDS_TB
struct RotOrder {
    pg8::StaticOrder S;
    __device__ void init(int M, int N, int G_, int c_) { S.init(M, N, G_, c_); }
    __device__ bool next(int i, pg8::Unit& u) const { if (!S.next(i, u)) return false; u.pn = (u.pn + (i >> 1)) & 7; return true; }
    __device__ __forceinline__ void a_ready(const pg8::Unit&) const {}
    __device__ __forceinline__ void done(const pg8::Unit&) const {}
};
struct Args { const float* in[19]; float* out; unsigned char* ws; int ph_lo, ph_hi, li, pad; };
constexpr int NPH_L = 10, NPH = 2 + NPH_L * NLAYER;

__global__ void __launch_bounds__(NTHR, 2) mk_fwd(Args args) {
    extern __shared__ __attribute__((aligned(16))) unsigned char lds_raw[];
    LAS unsigned char* lds = (LAS unsigned char*)lds_raw;
    volatile LAS unsigned* MISC = (volatile LAS unsigned*)(lds + MISC_OFF);
    const int tid0 = threadIdx.x;
    const int G = gridDim.x, bx = blockIdx.x, NGW = G * NWAVES;
    unsigned* ctl = (unsigned*)(args.ws + WS_CTL);
    for (int u = tid0; u < (LDS_BYTES - RING_BYTES) / 4; u += NTHR) ((LAS unsigned*)(lds + RING_BYTES))[u] = 0u;
    __syncthreads();
    XcdBarrier bar; bar.bar = ctl + CW_BAR + args.li * XCD_BAR_WORDS; bar.x = 0; bar.st = nullptr;
    if (MK_FUSED) bar = xcd_barrier_post(ctl + CW_BAR + args.li * XCD_BAR_WORDS, MISC + 8);
    const int lo = args.ph_lo, hi = args.ph_hi; (void)lo; (void)hi;
#ifndef PHMASK
#define PHMASK 0xffffffffu
#endif
#define IN(k) (lo <= (k) && (k) < hi)
#define PHON(i) ((PHMASK >> (i)) & 1u)
#define SEAM(k) do { if (IN(k) && IN((k) + 1)) xcd_barrier(bar); } while (0)

    typedef const Args __attribute__((address_space(4)))* ArgsP;
    unsigned char* ws0 = args.ws; ArgsP ap0 = (ArgsP)__builtin_amdgcn_kernarg_segment_ptr();
#define PHASE_BEGIN() unsigned char* wsp = ws0; ArgsP AP = ap0; int tid = tid0; asm volatile("" : "+s"(wsp), "+s"(AP), "+v"(tid)); \
    const int lane = tid & 63, wave = __builtin_amdgcn_readfirstlane(tid >> 6), gw = bx * NWAVES + wave; (void)lane; (void)gw
#define WSF(off) ((float*)ws_at(wsp, (off)))
#define WSB(off) ((bf16*)ws_at(wsp, (off)))
    if (PHON(0) && IN(0)) {
        PHASE_BEGIN(); float* CMOD = WSF(WS_CMOD); f32x2* ROPE = (f32x2*)ws_at(wsp, WS_ROPE); float* TB = WSF(WS_TB);
        LAS float* scr = (LAS float*)(lds + wave * 16384);
        for (int l = 0; l < NLAYER; ++l) {
            unsigned char* wl = ws_at(wsp, WS_W + l * W_LAYER);
#define PREP_MAT(W_, Ksrc_, Nsrc_, WT_, Kdst_, Ndst_, map_, ks_) do { const int nnb_ = (Ndst_) / 32, nit_ = ((Kdst_) / 64) * nnb_; \
                for (int it = gw; it < nit_; it += NGW) prep_item((W_), (Ksrc_), (Nsrc_), (WT_), (Kdst_), (map_), (ks_), scr, it / nnb_, it % nnb_, lane); } while (0)
            PREP_MAT(AP->in[7] + (size_t)l * DM * IN_W, DM, IN_W, (bf16*)ws_at(wl, WO_IN), DM, 2048, 0, (const float*)nullptr);
            PREP_MAT(AP->in[10] + (size_t)l * 256 * 768, 256, 768, (bf16*)ws_at(wl, WO_UQ), 256, 768, 1, AP->in[9] + l * 256);
            PREP_MAT(AP->in[12] + (size_t)l * 128 * 1024, 128, 1024, (bf16*)ws_at(wl, WO_UKV), 128, 1024, 1, AP->in[11] + l * 128);
            PREP_MAT(AP->in[14] + (size_t)l * DM * DM, DM, DM, (bf16*)ws_at(wl, WO_OUT), DM, DM, 1, AP->in[13] + l * DM);
            PREP_MAT(AP->in[17] + (size_t)l * DM * 2 * DFF, DM, 2 * DFF, (bf16*)ws_at(wl, WO_GU), DM, 2 * DFF, 2, (const float*)nullptr);
            if constexpr (PM8_L0 < 256 || PM8_L1 < 256) { PREP_MAT(AP->in[18] + (size_t)l * DFF * DM, DFF, DM, (bf16*)ws_at(wl, WO_DN), DFF, DM, 3, (const float*)nullptr); }
            for (int it = gw; it < (DFF / 64) * (DM / 32); it += NGW) prep_item8(AP->in[18] + (size_t)l * DFF * DM, DM, ws_at(wsp, WS_DN8 + l * DN8_LAYER), DFF, WDN_SC, scr, it / (DM / 32), it % (DM / 32), lane);
#undef PREP_MAT
        }
        __syncthreads();
        for (int i = bx * NTHR + tid; i < SEQ * 16; i += G * NTHR) { const int s = i >> 4, k = i & 15; float c, sn; sincos_acc((float)s * rope_invfreq(k), c, sn); ROPE[i] = (f32x2){c, sn}; }
        for (int i = bx * NTHR + tid; i < 4 * 132; i += G * NTHR) { const int h = i / 132, d = i % 132; const float* t5 = AP->in[2];
            WSF(WS_TB)[i] = (d < 128) ? (t5[t5_bucket_dev(d) * 4 + h] - t5[31 * 4 + h]) * LOG2E : 0.f; }
        for (int task = bx; task < NLAYER * 96; task += G) {
            const int l = task / 96, jc = task % 96;
            __syncthreads();
            LAS float* ca = (LAS float*)(lds + wave * 16384);
            for (int i = lane; i < 128 * 32; i += 64) { const int bb = i >> 7, kk = i & 127; const float cv = AP->in[1][bb * DM + wave * 128 + kk]; ca[kk * 32 + bb] = cv / (1.f + __expf(-cv)); }
            LDS_WAIT(); asm volatile("" ::: "memory");
            float accm[32];
#pragma unroll
            for (int i = 0; i < 32; ++i) accm[i] = 0.f;
            const float* wa = AP->in[3] + ((size_t)l * DM + wave * 128) * 6144 + jc * 64 + lane;
#pragma unroll 1
            for (int kk0 = 0; kk0 < 128; kk0 += 16) { float wq[16];
#pragma unroll
                for (int u = 0; u < 16; ++u) wq[u] = wa[(size_t)(kk0 + u) * 6144];
#pragma unroll
                for (int u = 0; u < 16; ++u) { const float w = wq[u];
#pragma unroll
                    for (int q4 = 0; q4 < 8; ++q4) { const f32x4 cv = *(const LAS f32x4*)(ca + (kk0 + u) * 32 + 4 * q4);
                        accm[4 * q4 + 0] += w * cv.x; accm[4 * q4 + 1] += w * cv.y; accm[4 * q4 + 2] += w * cv.z; accm[4 * q4 + 3] += w * cv.w; } } }
            __syncthreads();
            LAS float* red = (LAS float*)lds;
#pragma unroll
            for (int i = 0; i < 32; ++i) red[(wave * 32 + i) * 64 + lane] = accm[i];
            __syncthreads();
            for (int o = tid; o < 2048; o += NTHR) { const int bb = o >> 6, col = o & 63; float s = 0.f;
#pragma unroll
                for (int w = 0; w < 8; ++w) s += red[(w * 32 + bb) * 64 + col];
                const int j = jc * 64 + col, chunk = j >> 10, cc = j & 1023; const float mod = s + AP->in[4][l * 6144 + j];
                float r = mod;
                if (chunk == 1) r = AP->in[5][l * DM + cc] * (1.f + mod); else if (chunk == 2) r = mod * AP->in[6][l * DM + cc];
                else if (chunk == 4) r = AP->in[15][l * DM + cc] * (1.f + mod); else if (chunk == 5) r = mod * AP->in[16][l * DM + cc];
                CMOD[(((size_t)l * NB + bb) * 6 + chunk) * DM + cc] = r; }
        }
        __syncthreads();
    }
    SEAM(0);
    if (PHON(1) && IN(1)) { PHASE_BEGIN(); prenorm_rows(AP->in[0], WSF(WS_CMOD), 1, 0, WSB(WS_H), gw, NGW, lane); }
    SEAM(1);

    for (int l = 0; l < NLAYER; ++l) {
        const int pb = 2 + l * NPH_L;
        if (PHON(2) && IN(pb + 0)) { PHASE_BEGIN(); unsigned char* wl = ws_at(wsp, WS_W + l * W_LAYER); const float* cmod_l = WSF(WS_CMOD) + (size_t)l * NB * 6 * DM; (void)wl; (void)cmod_l;
            pg8::Gemm g{WSB(WS_H), (const bf16*)ws_at(wl, WO_IN), MTOK, 2048, DM}; RotOrder S; S.init(MTOK, 2048, G, bx);
            EpiInproj E{wsp, AP->in[8] + l * 4};
            pg8::gemm_phase<EpiInproj, RotOrder, true, true>(lds, g, S, E);
        }
        SEAM(pb + 0);
        if (PHON(3) && IN(pb + 1)) { PHASE_BEGIN(); unsigned char* wl = ws_at(wsp, WS_W + l * W_LAYER); const float* cmod_l = WSF(WS_CMOD) + (size_t)l * NB * 6 * DM; (void)wl; (void)cmod_l;
#ifndef P1_SEL
#define P1_SEL 7
#endif
            if (P1_SEL & 1) { fox_scan(WSF(WS_LOGF), WSF(WS_PSUM), WSB(WS_QF), WSB(WS_KF), gw, NGW, lane, (LAS float*)(lds + RING_BYTES + 9216 + wave * 256)  ); build_kmf(WSF(WS_KMP), WSB(WS_KMF), NGW - 1 - gw, NGW, lane); }
        }
        SEAM(pb + 1);
        if (PHON(4) && IN(pb + 2)) { PHASE_BEGIN(); unsigned char* wl = ws_at(wsp, WS_W + l * W_LAYER); const float* cmod_l = WSF(WS_CMOD) + (size_t)l * NB * 6 * DM; (void)wl; (void)cmod_l;
            const int vcu = (G % 8 == 0) ? (bx % 8) * (G / 8) + bx / 8 : bx;
#define UNIT_LIST(NP_, HEADS_, CALL_) do { const int npair_ = (vcu < (NP_)) ? ((NP_) - vcu + G - 1) / G : 0; \
                for (int u_ = 0; u_ < 2 * npair_; ++u_) { const int p = vcu + G * (u_ >> 1), bh = p >> 2, s = p & 3, b = bh / (HEADS_), h = bh % (HEADS_); const int qb = (u_ & 1) ? 7 - s : s; \
                    int nb = 0, nqb = -1; if (u_ + 1 < 2 * npair_) { const int p2 = vcu + G * ((u_ + 1) >> 1), bh2 = p2 >> 2, s2 = p2 & 3; if (bh2 % (HEADS_) == h) { nb = bh2 / (HEADS_); nqb = ((u_ + 1) & 1) ? 7 - s2 : s2; } } \
                    bool pre = false; if (u_ > 0) { const int p0 = vcu + G * ((u_ - 1) >> 1); pre = ((p0 >> 2) % (HEADS_)) == h; } \
                    CALL_; } } while (0)
            const bool gemm_first = ((vcu >> 2) & 1) != 0;
#pragma unroll 1
            for (int step = 0; step < 2; ++step) {
                if ((step == 0) == gemm_first) {
                if (P1_SEL & 2) { pg8::Gemm g{WSB(WS_CQ), (const bf16*)ws_at(wl, WO_UQ), MTOK, 768, 256}; pg8::StaticOrder S; S.init(MTOK, 768, G, bx);
                  EpiQup E{WSB(WS_QC), WSF(WS_CQSS), (const f32x2*)ws_at(wsp, WS_ROPE)}; pg8::gemm_phase<EpiQup, pg8::StaticOrder, true, true>(lds, g, S, E); }
                if (P1_SEL & 4) { pg8::Gemm g{WSB(WS_T7), (const bf16*)ws_at(wl, WO_UKV), MTOK, 1024, 128};   pg8::StaticOrder S; S.init(MTOK, 1024, G, bx);
                  EpiKVup E{WSB(WS_KC), WSB(WS_VC), WSF(WS_CKVSS)}; pg8::gemm_phase<EpiKVup, pg8::StaticOrder, true, true, false, true>(lds, g, S, E); }
                } else {
            UNIT_LIST(NB * 4 * 4, 4, (att::attn_unit_t<5, 0, 8, 4 * SEQ * 80, 80>(WSB(WS_QF) + h * 80, 320, WSB(WS_KF) + h * (SEQ * 80), WSB(WS_VF) + h * 64, 256, WSB(WS_O) + h * 64, b, qb, lds, nullptr, WSF(WS_OSS) + h, pre, nb, nqb)));
            int tb_h = -1;
            UNIT_LIST(NB * 4 * 4, 4, ({ if (h != tb_h) { __syncthreads(); if (tid < 256) { const int d = 191 - tid; ((LAS float*)(lds + ATTN_TB))[tid] = d < 0 ? -INFINITY : (d < 128 ? WSF(WS_TB)[h * 132 + d] : 0.f); } __syncthreads(); tb_h = h; }
                att::attn_unit_t<4, 1, 8, SEQ * 256, 256>(WSB(WS_QM) + h * 64, 256, WSB(WS_KM) + h * 64, WSB(WS_VM) + h * 64, 256, WSB(WS_O) + 256 + h * 64, b, qb, lds, (const float*)(WSB(WS_KMF) + (size_t)(b * 4 + h) * 4096), WSF(WS_OSS) + 4 + h, pre, nb, nqb); }));
                }
            }
#undef UNIT_LIST
        }
        SEAM(pb + 2);
        if (PHON(5) && IN(pb + 3)) { PHASE_BEGIN(); unsigned char* wl = ws_at(wsp, WS_W + l * W_LAYER); const float* cmod_l = WSF(WS_CMOD) + (size_t)l * NB * 6 * DM; (void)wl; (void)cmod_l;
            const int vcu = (G % 8 == 0) ? (bx % 8) * (G / 8) + bx / 8 : bx;
#define UNIT_LIST(NP_, HEADS_, CALL_) do { const int npair_ = (vcu < (NP_)) ? ((NP_) - vcu + G - 1) / G : 0; \
                for (int u_ = 0; u_ < 2 * npair_; ++u_) { const int p = vcu + G * (u_ >> 1), bh = p >> 2, s = p & 3, b = bh / (HEADS_), h = bh % (HEADS_); const int qb = (u_ & 1) ? 7 - s : s; \
                    int nb = 0, nqb = -1; if (u_ + 1 < 2 * npair_) { const int p2 = vcu + G * ((u_ + 1) >> 1), bh2 = p2 >> 2, s2 = p2 & 3; if (bh2 % (HEADS_) == h) { nb = bh2 / (HEADS_); nqb = ((u_ + 1) & 1) ? 7 - s2 : s2; } } \
                    bool pre = false; if (u_ > 0) { const int p0 = vcu + G * ((u_ - 1) >> 1); pre = ((p0 >> 2) % (HEADS_)) == h; } \
                    CALL_; } } while (0)
            UNIT_LIST(NB * 8 * 4, 8, (att::attn_unit_t<6, 0, 8, 8 * SEQ * 64, 64>(WSB(WS_QC) + h * 96, 768, WSB(WS_KC) + h * (SEQ * 64), WSB(WS_VC) + h * 64, 512, WSB(WS_O) + 512 + h * 64, b, qb, lds, nullptr, WSF(WS_OSS) + 8 + h, pre, nb, nqb, WSB(WS_KR))));
#undef UNIT_LIST
        }
        SEAM(pb + 3);
        if (PHON(6) && IN(pb + 4)) { PHASE_BEGIN();
            for (int m = bx * NTHR + tid; m < MTOK; m += G * NTHR) { const GAS f32x4* sp = (const GAS f32x4*)(WSF(WS_OSS) + (size_t)m * 16); const f32x4 a = sp[0], c = sp[1], d = sp[2], e = sp[3];
                const float r0 = fast_rsqrt(((a.x + a.y) + (a.z + a.w)) * (1.f / 256.f) + RMS_EPS), r1 = fast_rsqrt(((c.x + c.y) + (c.z + c.w)) * (1.f / 256.f) + RMS_EPS);
                const float r2 = fast_rsqrt((((d.x + d.y) + (d.z + d.w)) + ((e.x + e.y) + (e.z + e.w))) * (1.f / 512.f) + RMS_EPS);
                *(GAS f32x4*)(WSF(WS_F) + (size_t)m * 4) = (f32x4){r0 / r1, r1 / r2, r2, 0.f}; } }
        SEAM(pb + 4);
        if (PHON(7) && IN(pb + 5)) { PHASE_BEGIN(); unsigned char* wl = ws_at(wsp, WS_W + l * W_LAYER); const float* cmod_l = WSF(WS_CMOD) + (size_t)l * NB * 6 * DM; (void)wl; (void)cmod_l;
            pg8::Gemm g{WSB(WS_O), (const bf16*)ws_at(wl, WO_OUT), MTOK, DM, DM}; pg8::StaticOrder S; S.init(MTOK, DM, G, bx);
            EpiYks E{WSB(WS_Y), WSF(WS_YSS), WSF(WS_F), (LAS float*)(lds + RING_BYTES + 1024)}; pg8::gemm_phase<EpiYks, pg8::StaticOrder, true, true>(lds, g, S, E);
        }
        SEAM(pb + 5);
        if (PHON(8) && IN(pb + 6)) { PHASE_BEGIN(); unsigned char* wl = ws_at(wsp, WS_W + l * W_LAYER); const float* cmod_l = WSF(WS_CMOD) + (size_t)l * NB * 6 * DM; (void)wl; (void)cmod_l;
            if (l == 0) post_rows<false, true>(AP->in[0], WSB(WS_XB), WSB(WS_Y), WSF(WS_YSS), RMS_EPS, cmod_l, 2, true, cmod_l, 4, 3, WSB(WS_H), gw, NGW, lane);
            else post_rows<true, true>(WSB(WS_XB), WSB(WS_XB), WSB(WS_Y), WSF(WS_YSS), RMS_EPS, cmod_l, 2, true, cmod_l, 4, 3, WSB(WS_H), gw, NGW, lane); }
        SEAM(pb + 6);
        if (PHON(9) && IN(pb + 7)) { PHASE_BEGIN(); unsigned char* wl = ws_at(wsp, WS_W + l * W_LAYER); const float* cmod_l = WSF(WS_CMOD) + (size_t)l * NB * 6 * DM; (void)wl; (void)cmod_l;
            pg8::Gemm g{WSB(WS_H), (const bf16*)ws_at(wl, WO_GU), MTOK, 2 * DFF, DM}; pg8::StaticOrder S; S.init(MTOK, 2 * DFF, G, bx);
            EpiSwiglu E{WSB(WS_ACT), ws_at(wsp, WS_ACT8), l == 0 ? PM8_L0 : PM8_L1}; pg8::gemm_phase<EpiSwiglu, pg8::StaticOrder, true, true>(lds, g, S, E);
        }
        SEAM(pb + 7);
        if (PHON(10) && IN(pb + 8)) { PHASE_BEGIN(); unsigned char* wl = ws_at(wsp, WS_W + l * W_LAYER); const float* cmod_l = WSF(WS_CMOD) + (size_t)l * NB * 6 * DM; (void)wl; (void)cmod_l;
            const int m8 = (l == 0 ? PM8_L0 : PM8_L1) * 256;
            if (m8 > 0) { pg8::Gemm g{(const bf16*)ws_at(wsp, WS_ACT8), (const bf16*)ws_at(wsp, WS_DN8 + l * DN8_LAYER), m8, DM, DFF / 2}; pg8::StaticOrder S; S.init(m8, DM, G, bx);
                EpiY E{WSB(WS_Y), WSF(WS_YSS)}; pg8::gemm_phase<EpiY, pg8::StaticOrder, true, true, true>(lds, g, S, E); }
            if (m8 < MTOK) { pg8::Gemm g{WSB(WS_ACT) + (size_t)m8 * DFF, (const bf16*)ws_at(wl, WO_DN), MTOK - m8, DM, DFF}; pg8::StaticOrder S; S.init(MTOK - m8, DM, G, bx);
                EpiY E{WSB(WS_Y) + (size_t)m8 * DM, WSF(WS_YSS) + (size_t)m8 * 16}; pg8::gemm_phase<EpiY, pg8::StaticOrder, true, true>(lds, g, S, E); }
        }
        SEAM(pb + 8);
        if (PHON(11) && IN(pb + 9)) { PHASE_BEGIN(); unsigned char* wl = ws_at(wsp, WS_W + l * W_LAYER); const float* cmod_l = WSF(WS_CMOD) + (size_t)l * NB * 6 * DM; (void)wl; (void)cmod_l;
            if (l + 1 < NLAYER) post_rows<true, true>(WSB(WS_XB), WSB(WS_XB), WSB(WS_Y), WSF(WS_YSS), RMS_EPS / (DN_OSC * DN_OSC), cmod_l, 5, true, cmod_l + (size_t)NB * 6 * DM, 1, 0, WSB(WS_H), gw, NGW, lane);
            else post_rows<true, false>(WSB(WS_XB), AP->out, WSB(WS_Y), WSF(WS_YSS), RMS_EPS / (DN_OSC * DN_OSC), cmod_l, 5, false, cmod_l, 1, 0, WSB(WS_H), gw, NGW, lane); }
        SEAM(pb + 9);
    }
#undef IN
#undef SEAM
}

extern "C" void kernel_launch(void* const* d_in, const int* in_sizes, int n_in, void* d_out, int out_size, void* d_ws, size_t ws_size, hipStream_t stream) {
    static int grid = 0;
    if (grid == 0) {
        if (n_in != 19 || in_sizes[0] != MTOK * DM || out_size != MTOK * DM || ws_size < WS_END) { fprintf(stderr, "kernel_launch: unexpected shapes / workspace (n_in %d, ws %zu); nothing launched\n", n_in, ws_size); grid = -1; return; }
        int dev = 0, cus = 0, per_cu = 0;
        if (hipGetDevice(&dev) != hipSuccess || hipDeviceGetAttribute(&cus, hipDeviceAttributeMultiprocessorCount, dev) != hipSuccess) { grid = -1; return; }
        if (hipFuncSetAttribute((const void*)mk_fwd, hipFuncAttributeMaxDynamicSharedMemorySize, LDS_BYTES) != hipSuccess) { fprintf(stderr, "kernel_launch: hipFuncSetAttribute failed\n"); grid = -1; return; }
        if (hipOccupancyMaxActiveBlocksPerMultiprocessor(&per_cu, (const void*)mk_fwd, NTHR, LDS_BYTES) != hipSuccess || per_cu < 1) { fprintf(stderr, "kernel_launch: occupancy query reports %d\n", per_cu); }
        (void)hipGetLastError();
        grid = cus;
    }
    if (grid < 0) return;
    if (hipMemsetAsync((char*)d_ws + WS_CTL, 0, CTL_ZERO_BYTES, stream) != hipSuccess) return;
    Args a{};
    for (int i = 0; i < 19; ++i) a.in[i] = (const float*)d_in[i];
    a.out = (float*)d_out; a.ws = (unsigned char*)d_ws; a.pad = 0;
#if MK_FUSED
    a.ph_lo = 0; a.ph_hi = NPH; a.li = 0;
    hipLaunchKernelGGL(mk_fwd, dim3(grid), dim3(NTHR), LDS_BYTES, stream, a);
#else
#ifndef PROBE_REPMASK
#define PROBE_REPMASK 0u
#endif
    for (int p = 0; p < NPH; ++p) { const int reps = ((PROBE_REPMASK >> p) & 1u) ? 2 : 1;
        for (int r = 0; r < reps; ++r) { a.ph_lo = p; a.ph_hi = p + 1; a.li = 0; hipLaunchKernelGGL(mk_fwd, dim3(grid), dim3(NTHR), LDS_BYTES, stream, a); } }
#endif
}
```

```cpp
#include <hip/hip_runtime.h>
#include <cstdio>
#include <cstdint>
namespace pg8 {
#define PG8_LAS __attribute__((address_space(3)))
typedef unsigned short bf16_t;
typedef short bf16x8 __attribute__((ext_vector_type(8)));
typedef float f32x4 __attribute__((ext_vector_type(4)));
typedef unsigned u32x4 __attribute__((ext_vector_type(4)));
typedef int i32x8 __attribute__((ext_vector_type(8)));
__device__ __forceinline__ const char* uptr(const char* p) { const unsigned long long v = (unsigned long long)p;
    const unsigned lo = (unsigned)__builtin_amdgcn_readfirstlane((int)(unsigned)v), hi = (unsigned)__builtin_amdgcn_readfirstlane((int)(unsigned)(v >> 32)); return (const char*)(((unsigned long long)hi << 32) | lo); }
__device__ __forceinline__ void mfma_f8_inplace(f32x4& c, i32x8 a, i32x8 b) { asm volatile("v_mfma_f32_16x16x128_f8f6f4 %0, %1, %2, %0" : "+v"(c) : "v"(a), "v"(b)); }
template <bool OFFS> __device__ __forceinline__ auto tile_pos(const char* base) { if constexpr (OFFS) return 0u; else return base; }
__device__ __forceinline__ void glds_sa(unsigned voff, const void* sbase, unsigned lds_dst) { unsigned keep;
    asm volatile("s_mov_b32 %0, m0\n\ts_mov_b32 m0, %2\n\ts_nop 0\n\tglobal_load_lds_dwordx4 %1, %3\n\ts_mov_b32 m0, %0" : "=&s"(keep) : "v"(voff), "s"(lds_dst), "s"(sbase) : "memory"); }
constexpr int BM = 256, BK = 64, HALF = 128, HTB = HALF * BK * 2  , STAGE_BYTES = 8 * HTB, NXCD = 8, WGM = 8;

__host__ __device__ __forceinline__ int lds_byte(int r, int c) { const int st = (r >> 4) * 2 + (c >> 5), rr = r & 15, cc = c & 31, ob = rr * 64 + cc * 2; return st * 1024 + (ob ^ (((ob >> 9) & 1) << 5)); }
__host__ __device__ __forceinline__ void stage_rc(int b, int& R, int& C) { const int st = b / 1024, sb = b % 1024, swz = sb ^ (((sb >> 9) & 1) << 5); R = (st >> 1) * 16 + swz / 64; C = (st & 1) * 32 + (swz % 64) / 2; }
__host__ __device__ __forceinline__ int perm32(int rho) { const int n = rho >> 4, i = rho & 15; return 8 * (i >> 2) + 4 * n + (i & 3); }

struct Unit { int pm, pn; };
struct Gemm { const bf16_t* A; const bf16_t* Bt; int M, N, K; };

struct StaticOrder {
    int nM, nN, nwg, G, c;
    __host__ __device__ void init(int M, int N, int G_, int c_) { nM = M / BM; nN = N / BM; nwg = nM * nN; G = G_; c = c_; }
    __host__ __device__ __forceinline__ bool next(int i, Unit& u) const {
        const long L = (long)i * G + c; if (L >= nwg) return false;
        int wgid = (int)L; { const int q = nwg / NXCD, r = nwg % NXCD, xcd = wgid % NXCD, off = wgid / NXCD; wgid = (xcd < r ? xcd * (q + 1) : r * (q + 1) + (xcd - r) * q) + off; }
        const int nig = WGM * nN, gid = wgid / nig, fm = gid * WGM, gsz = (nM - fm) < WGM ? (nM - fm) : WGM;
        u.pm = fm + ((wgid % nig) % gsz); u.pn = (wgid % nig) / gsz; return true;
    }
    __device__ __forceinline__ void a_ready(const Unit&) const {}
    __device__ __forceinline__ void done(const Unit&) const {}
};

__device__ __forceinline__ unsigned cvt_pk_bf16(float lo, float hi) { unsigned r; asm volatile("v_cvt_pk_bf16_f32 %0, %1, %2" : "=v"(r) : "v"(lo), "v"(hi)); return r; }
typedef float f32x2 __attribute__((ext_vector_type(2)));
template <class Epi, class Sched, bool ALIGN_EPI = false, bool SP2 = false, bool F8 = false, bool SA = F8>
__device__ __forceinline__ void gemm_phase(PG8_LAS unsigned char* lds, const Gemm g, const Sched& S, const Epi& E) {
    int tid = threadIdx.x; asm volatile("" : "+v"(tid));
    const int wid = __builtin_amdgcn_readfirstlane(tid >> 6), lane = tid & 63, wr = wid >> 2, wc = wid & 3, fr = lane & 15, fq = lane >> 4;
    const int K = g.K, nt = K / BK;
    unsigned voffA[2], voffB[2];
#pragma unroll
    for (int i = 0; i < 2; ++i) { int R, C; stage_rc(tid * 16 + i * 8192, R, C); const int Rb = Epi::PERM ? ((R & ~31) + perm32(R & 31)) : R;
        voffA[i] = (unsigned)(R * K + C) * 2u; voffB[i] = (unsigned)(Rb * K + C) * 2u; }
    const unsigned kstep = (unsigned)(BK * 2);
    const unsigned hstep = (unsigned)HALF * (unsigned)K * 2u;
    const unsigned tstep = 2u * hstep;
    const unsigned ldsu = (unsigned)__builtin_amdgcn_readfirstlane((int)((unsigned)(uintptr_t)lds + (unsigned)wid * 1024u)); (void)ldsu;
    const unsigned ldsw = (unsigned)wid * 1024u;
    const int aoff = lds_byte(wr * 64 + fr, fq * 8), boff = lds_byte(wc * 32 + fr, fq * 8);
#define PG8_SA(b, h) (((b) * 2 + (h)) * HTB)
#define PG8_SB(b, h) ((4 + (b) * 2 + (h)) * HTB)
#define PG8_HOF(bufoff) (((((bufoff) / HTB) & 1) != 0) ? hstep : 0u)
#define PG8_STAGE(bufoff, gbase, voff) do { _Pragma("unroll") for (int _i = 0; _i < 2; ++_i) { \
        if constexpr (SA) glds_sa((voff)[_i] + (gbase), ((bufoff) < 4 * HTB) ? (((((bufoff) / HTB) & 1) != 0) ? gAh : gA) : (((((bufoff) / HTB) & 1) != 0) ? gBh : gB), ldsu + (unsigned)((bufoff) + _i * 8192)); \
        else __builtin_amdgcn_global_load_lds((const unsigned*)((gbase) + PG8_HOF(bufoff) + (voff)[_i]), (PG8_LAS unsigned*)(lds + (bufoff) + ldsw + _i * 8192), 16, 0, 0); } } while (0)
#define PG8_LDA(dst, b, h) do { _Pragma("unroll") for (int m = 0; m < 4; ++m) _Pragma("unroll") for (int k = 0; k < 2; ++k) dst[m][k] = *(const PG8_LAS bf16x8*)(lds + PG8_SA(b, h) + aoff + m * 2048 + k * 1024); } while (0)
#define PG8_LDB(dst, b, h) do { _Pragma("unroll") for (int n = 0; n < 2; ++n) _Pragma("unroll") for (int k = 0; k < 2; ++k) dst[n][k] = *(const PG8_LAS bf16x8*)(lds + PG8_SB(b, h) + boff + n * 2048 + k * 1024); } while (0)
#define PG8_CAT(x) __builtin_bit_cast(i32x8, __builtin_shufflevector((x)[0], (x)[1], 0, 1, 2, 3, 4, 5, 6, 7, 8, 9, 10, 11, 12, 13, 14, 15))
#define PG8_MMA(ai, bj, At, Bt) do { __builtin_amdgcn_s_setprio(1); _Pragma("unroll") for (int m = 0; m < 4; ++m) _Pragma("unroll") for (int n = 0; n < 2; ++n) { \
        if constexpr (F8) mfma_f8_inplace(acc[ai][bj][m][n], PG8_CAT(Bt[n]), PG8_CAT(At[m])); \
        else { _Pragma("unroll") for (int k = 0; k < 2; ++k) acc[ai][bj][m][n] = __builtin_amdgcn_mfma_f32_16x16x32_bf16(Bt[n][k], At[m][k], acc[ai][bj][m][n], 0, 0, 0); } } __builtin_amdgcn_s_setprio(0); } while (0)
#define PG8_WAIT_V(n) asm volatile("s_waitcnt vmcnt(" #n ")" ::: "memory")
#define PG8_WAIT_L(n) asm volatile("s_waitcnt lgkmcnt(" #n ")" ::: "memory")
#define PG8_BAR __builtin_amdgcn_s_barrier()
#define PG8_SCHED __builtin_amdgcn_sched_barrier(0)
    const char* const gA = uptr((const char*)g.A); const char* const gB = uptr((const char*)g.Bt); const char* const gAh = uptr((const char*)g.A + hstep); const char* const gBh = uptr((const char*)g.Bt + hstep); (void)gA; (void)gB; (void)gAh; (void)gBh;
    using TP = __typeof__(tile_pos<SA>((const char*)nullptr));
    Unit cur, nxt; int ui = 0;
    if (!S.next(0, cur)) return;
    cur.pm = __builtin_amdgcn_readfirstlane(cur.pm); cur.pn = __builtin_amdgcn_readfirstlane(cur.pn);
    f32x4 acc[2][2][4][2];
#pragma unroll
    for (int a = 0; a < 2; ++a)
#pragma unroll
        for (int b = 0; b < 2; ++b)
#pragma unroll
            for (int m = 0; m < 4; ++m)
#pragma unroll
                for (int n = 0; n < 2; ++n) acc[a][b][m][n] = (f32x4){0.f, 0.f, 0.f, 0.f};
    bf16x8 At[4][2], B0[2][2], B1[2][2];
    TP cA = tile_pos<SA>((const char*)g.A) + (unsigned)cur.pm * tstep; TP cB = tile_pos<SA>((const char*)g.Bt) + (unsigned)cur.pn * tstep;
    S.a_ready(cur);
    if constexpr (Epi::KSCALE) E.prep(cur, 0, wid, lane);
    if constexpr (SP2) {
        PG8_STAGE(PG8_SB(0, 0), cB, voffB); PG8_STAGE(PG8_SB(0, 1), cB, voffB); PG8_STAGE(PG8_SA(0, 0), cA, voffA); PG8_STAGE(PG8_SA(0, 1), cA, voffA);
        if (wr == 1) PG8_BAR;
        PG8_WAIT_V(2); PG8_BAR;
        PG8_STAGE(PG8_SB(1, 0), cB + kstep, voffB); PG8_STAGE(PG8_SA(1, 0), cA + kstep, voffA); PG8_STAGE(PG8_SB(1, 1), cB + kstep, voffB);
        PG8_WAIT_V(6); PG8_BAR;
    } else {
        PG8_STAGE(PG8_SB(0, 0), cB, voffB); PG8_STAGE(PG8_SA(0, 0), cA, voffA); PG8_STAGE(PG8_SB(0, 1), cB, voffB); PG8_STAGE(PG8_SA(0, 1), cA, voffA);
        if (wr == 1) PG8_BAR;
        PG8_WAIT_V(4); PG8_BAR;
        PG8_STAGE(PG8_SB(1, 0), cB + kstep, voffB); PG8_STAGE(PG8_SA(1, 0), cA + kstep, voffA); PG8_STAGE(PG8_SB(1, 1), cB + kstep, voffB);
        PG8_WAIT_V(6); PG8_BAR;
    }
    for (;;) {
        const bool has_next = S.next(ui + 1, nxt);
        nxt.pm = __builtin_amdgcn_readfirstlane(nxt.pm); nxt.pn = __builtin_amdgcn_readfirstlane(nxt.pn);
        const TP nA = has_next ? tile_pos<SA>((const char*)g.A) + (unsigned)nxt.pm * tstep : cA; const TP nB = has_next ? tile_pos<SA>((const char*)g.Bt) + (unsigned)nxt.pn * tstep : cB;
#pragma unroll 1
        for (int t = 0; t < nt; t += 2) {
            const bool last = (t == nt - 2);
            const TP a1 = cA + (unsigned)(t + 1) * kstep;
            const TP a2 = last ? nA : cA + (unsigned)(t + 2) * kstep; const TP b2 = last ? nB : cB + (unsigned)(t + 2) * kstep;
            const TP a3 = a2 + kstep; const TP b3 = b2 + kstep;
            if (last && has_next) { S.a_ready(nxt); if constexpr (Epi::KSCALE) E.prep(nxt, (ui + 1) & 1, wid, lane); }
            if constexpr (Epi::KSCALE) { if (t == 4 || t == 8) E.kscale(acc, ui & 1, t == 4 ? 0 : 1, wr, fr); }
            if constexpr (SP2) {
            PG8_LDB(B0, 0, 0); PG8_LDB(B1, 0, 1); PG8_SCHED; PG8_LDA(At, 0, 0); PG8_STAGE(PG8_SA(1, 1), a1, voffA);
            PG8_WAIT_V(8); PG8_WAIT_L(0); PG8_BAR; PG8_MMA(0, 0, At, B0); PG8_MMA(0, 1, At, B1); PG8_BAR; PG8_SCHED;
            PG8_LDA(At, 0, 1); PG8_STAGE(PG8_SB(0, 0), b2, voffB); PG8_STAGE(PG8_SB(0, 1), b2, voffB); PG8_STAGE(PG8_SA(0, 0), a2, voffA);
            PG8_WAIT_V(8); PG8_WAIT_L(0); PG8_BAR; PG8_MMA(1, 0, At, B0); PG8_MMA(1, 1, At, B1); PG8_BAR; PG8_SCHED;
            PG8_LDB(B0, 1, 0); PG8_LDB(B1, 1, 1); PG8_SCHED; PG8_LDA(At, 1, 0); PG8_STAGE(PG8_SA(0, 1), a2, voffA);
            PG8_WAIT_V(8); PG8_WAIT_L(0); PG8_BAR; PG8_MMA(0, 0, At, B0); PG8_MMA(0, 1, At, B1); PG8_BAR; PG8_SCHED;
            PG8_LDA(At, 1, 1); PG8_STAGE(PG8_SB(1, 0), b3, voffB); PG8_STAGE(PG8_SB(1, 1), b3, voffB); PG8_STAGE(PG8_SA(1, 0), a3, voffA);
            PG8_WAIT_V(8); PG8_WAIT_L(0); PG8_BAR; PG8_MMA(1, 0, At, B0); PG8_MMA(1, 1, At, B1); PG8_BAR; PG8_SCHED;
            } else {
            PG8_LDB(B0, 0, 0); PG8_SCHED; PG8_LDA(At, 0, 0); PG8_STAGE(PG8_SA(1, 1), a1, voffA);
            PG8_WAIT_L(8); PG8_BAR; PG8_WAIT_L(0); PG8_MMA(0, 0, At, B0); PG8_BAR; PG8_SCHED;
            PG8_LDB(B1, 0, 1); PG8_STAGE(PG8_SB(0, 0), b2, voffB);
            PG8_BAR; PG8_WAIT_L(0); PG8_MMA(0, 1, At, B1); PG8_BAR;
            PG8_LDA(At, 0, 1); PG8_STAGE(PG8_SA(0, 0), a2, voffA);
            PG8_BAR; PG8_WAIT_L(0); PG8_MMA(1, 0, At, B0); PG8_BAR; PG8_SCHED;
            PG8_STAGE(PG8_SB(0, 1), b2, voffB);
            PG8_WAIT_V(6); PG8_BAR; PG8_MMA(1, 1, At, B1); PG8_BAR;
            PG8_LDB(B0, 1, 0); PG8_SCHED; PG8_LDA(At, 1, 0); PG8_STAGE(PG8_SA(0, 1), a2, voffA);
            PG8_WAIT_L(8); PG8_BAR; PG8_WAIT_L(0); PG8_MMA(0, 0, At, B0); PG8_BAR; PG8_SCHED;
            PG8_LDB(B1, 1, 1); PG8_STAGE(PG8_SB(1, 0), b3, voffB);
            PG8_BAR; PG8_WAIT_L(0); PG8_MMA(0, 1, At, B1); PG8_BAR;
            PG8_LDA(At, 1, 1); PG8_STAGE(PG8_SA(1, 0), a3, voffA);
            PG8_BAR; PG8_WAIT_L(0); PG8_MMA(1, 0, At, B0); PG8_BAR; PG8_SCHED;
            PG8_STAGE(PG8_SB(1, 1), b3, voffB);
            PG8_WAIT_V(6); PG8_BAR; PG8_MMA(1, 1, At, B1); PG8_BAR;
            }
        }
        if constexpr (F8) asm volatile("s_nop 15\n\ts_nop 15" ::: "memory");
        if constexpr (ALIGN_EPI) { if (wr == 0) PG8_BAR; }
        if constexpr (Epi::KSCALE) E.kscale(acc, ui & 1, 2, wr, fr);
        if constexpr (!Epi::AFTER_DRAIN) { E(acc, cur, wr, wc, fr, fq); S.done(cur); }
        if (!has_next) break;
#pragma unroll
        for (int a = 0; a < 2; ++a)
#pragma unroll
            for (int b = 0; b < 2; ++b)
#pragma unroll
                for (int m = 0; m < 4; ++m)
#pragma unroll
                    for (int n = 0; n < 2; ++n) acc[a][b][m][n] = (f32x4){0.f, 0.f, 0.f, 0.f};
        cur = nxt; cA = nA; cB = nB; ++ui;
        if constexpr (ALIGN_EPI) { if (wr == 1) PG8_BAR; }
    }
    PG8_WAIT_V(0);
    if constexpr (!ALIGN_EPI) { if (wr == 0) PG8_BAR; }
    PG8_BAR;
    if constexpr (Epi::AFTER_DRAIN) { E.fused(acc, cur, wr, wc, fr, fq, lds, wid, lane); S.done(cur); }
#undef PG8_SA
#undef PG8_SB
#undef PG8_STAGE
#undef PG8_HOF
#undef PG8_LDA
#undef PG8_LDB
#undef PG8_MMA
#undef PG8_CAT
#undef PG8_WAIT_V
#undef PG8_WAIT_L
#undef PG8_BAR
#undef PG8_SCHED
}
}
#define LAS __attribute__((address_space(3)))
#define XB_TMO      128
#define XB_XCNT(j)  (256  + 64 * (j))
#define XB_XSUB(j)  (1280 + 64 * (j))
#define XB_XGEN(j)  (2304 + 64 * (j))
#define XB_TOP      3328
#define XB_TOPGEN   3392
#define XCD_BAR_WORDS 3456
#define XB_SPIN_CAP (1u << 18)

__device__ __forceinline__ unsigned xb_ld(unsigned* p)              { return __hip_atomic_load(p, __ATOMIC_RELAXED, __HIP_MEMORY_SCOPE_AGENT); }
__device__ __forceinline__ unsigned xb_add(unsigned* p, unsigned v) { return __hip_atomic_fetch_add(p, v, __ATOMIC_RELAXED, __HIP_MEMORY_SCOPE_AGENT); }
__device__ __forceinline__ unsigned xb_xcc_id() { return (unsigned)__builtin_amdgcn_s_getreg((3 << 11) | 20) & 0xFu; }
#define XB_SPIN(cond, bar) do { unsigned _sp = 0; while (cond) { __builtin_amdgcn_s_sleep(1); \
    if ((++_sp & 255u) == 0u) { if (xb_ld(&(bar)[XB_TMO])) break; if (_sp > XB_SPIN_CAP) { atomicAdd(&(bar)[XB_TMO], 1u); break; } } } } while (0)

struct XcdBarrier {
    unsigned* bar; unsigned x;
    volatile LAS unsigned* st;
};

__device__ __forceinline__ XcdBarrier xcd_barrier_post(unsigned* bar, volatile LAS unsigned* st) {
    XcdBarrier b; b.bar = bar; b.x = xb_xcc_id(); b.st = st;
    if (threadIdx.x == 0) (void)xb_add(&bar[XB_XCNT(b.x)], 1u);
    return b;
}
__device__ __forceinline__ void xcd_barrier_complete(unsigned* bar, unsigned x, unsigned& nloc, unsigned& nx) {
    const unsigned G = gridDim.x * gridDim.y * gridDim.z;
    unsigned sum, cnt, mine, sp = 0u;
    for (;;) {
        sum = 0u; cnt = 0u; mine = 0u;
#pragma unroll
        for (unsigned j = 0; j < 16; ++j) { const unsigned c = xb_ld(&bar[XB_XCNT(j)]); sum += c; cnt += (c > 0u) ? 1u : 0u; mine = (j == x) ? c : mine; }
        if (sum == G) break;
        __builtin_amdgcn_s_sleep(1);
        if ((++sp & 255u) == 0u) { if (xb_ld(&bar[XB_TMO])) break; if (sp > XB_SPIN_CAP) { atomicAdd(&bar[XB_TMO], 1u); break; } }
    }
    nloc = mine > 0u ? mine : 1u; nx = cnt > 0u ? cnt : 1u;
}

__device__ __forceinline__ void xcd_barrier(const XcdBarrier& b) {
    asm volatile("s_waitcnt vmcnt(0)" ::: "memory");
    __syncthreads();
    if (threadIdx.x == 0) {
        unsigned* bar = b.bar;
        __builtin_amdgcn_s_waitcnt(0);
        unsigned nloc = b.st[0], nx = b.st[1];
        if (nloc == 0u) { xcd_barrier_complete(bar, b.x, nloc, nx); b.st[0] = nloc; b.st[1] = nx; }
        const unsigned old = xb_add(&bar[XB_XSUB(b.x)], 1u);
        const unsigned gen = old / nloc;
        if (old + 1u == (gen + 1u) * nloc) {
            __builtin_amdgcn_fence(__ATOMIC_RELEASE, "agent");
            asm volatile("s_waitcnt vmcnt(0)" ::: "memory");
            const unsigned og = xb_add(&bar[XB_TOP], 1u);
            const unsigned tg = og / nx;
            if (og + 1u == (tg + 1u) * nx) xb_add(&bar[XB_TOPGEN], 1u);
            else XB_SPIN(xb_ld(&bar[XB_TOPGEN]) == tg, bar);
            __builtin_amdgcn_fence(__ATOMIC_ACQUIRE, "agent");
            xb_add(&bar[XB_XGEN(b.x)], 1u);
            asm volatile("s_waitcnt vmcnt(0)" ::: "memory");
        } else {
            XB_SPIN(xb_ld(&bar[XB_XGEN(b.x)]) == gen, bar);
            __builtin_amdgcn_fence(__ATOMIC_ACQUIRE, "agent");
            asm volatile("s_waitcnt vmcnt(0)" ::: "memory");
        }
    }
    __syncthreads();
}
#ifndef MK_FUSED
#define MK_FUSED 1
#endif
constexpr int NB = 32, SEQ = 2048, DM = 1024, MTOK = NB * SEQ, NLAYER = 2, DFF = 2816, IN_W = 1956;
constexpr float RMS_EPS = 1e-6f, LOG2E = 1.4426950408889634f;
constexpr float C2_64 = 0.125f * LOG2E, C2_96 = 0.10206207261596577f * LOG2E;
constexpr int NWAVES = 8, NTHR = 512;
typedef float f32x2 __attribute__((ext_vector_type(2)));
typedef float f32x16 __attribute__((ext_vector_type(16)));
typedef unsigned u32x2 __attribute__((ext_vector_type(2)));

constexpr size_t MiB = 1u << 20;
constexpr size_t WS_CTL = 0, CTL_ZERO_BYTES = 1 * MiB;
constexpr size_t WS_CMOD = 1 * MiB;
constexpr size_t WS_ROPE = 3 * MiB;
constexpr size_t WS_TB = 3 * MiB + 512 * 1024;
constexpr size_t WS_PSUM = 3 * MiB + 512 * 1024 + 4096;
constexpr size_t WS_KMP = 4 * MiB;
constexpr size_t WS_LOGF = 5 * MiB;
constexpr size_t WS_CQSS = 6 * MiB;
constexpr size_t WS_CKVSS = 7 * MiB;
constexpr size_t WS_YSS = 8 * MiB;
constexpr size_t WS_OSS = 12 * MiB;
constexpr size_t WS_KMF = WS_YSS;
constexpr size_t WS_F = WS_LOGF;
constexpr size_t WS_W = 16 * MiB, W_LAYER = 24 * MiB;
constexpr size_t WO_IN = 0, WO_UQ = 4 * MiB, WO_UKV = 4 * MiB + 512 * 1024, WO_OUT = 5 * MiB, WO_GU = 7 * MiB, WO_DN = 18 * MiB;
constexpr size_t WS_H = 64 * MiB;
constexpr size_t WS_QF = 192 * MiB, WS_KF = 232 * MiB, WS_VF = 272 * MiB, WS_QM = 304 * MiB, WS_KM = 336 * MiB, WS_VM = 368 * MiB;
constexpr size_t WS_CQ = 400 * MiB, WS_T7 = 432 * MiB, WS_QC = 464 * MiB, WS_KC = 560 * MiB, WS_VC = 656 * MiB;
constexpr size_t WS_ACT = 192 * MiB;
constexpr size_t WS_ACT8 = 544 * MiB;
constexpr size_t WS_DN8 = 976 * MiB, DN8_LAYER = 3 * MiB;
constexpr int PM8_L0 = 256, PM8_L1 = 256;
constexpr float ACT_SC = 4.f, WDN_SC = 512.f, DN_OSC = 1.f / (ACT_SC * WDN_SC);
constexpr size_t WS_KR = 624 * MiB;
constexpr size_t WS_O = 720 * MiB, WS_Y = WS_H  , WS_XB = 848 * MiB  , WS_END = 982 * MiB;
constexpr int CW_BAR = 4096;

constexpr int RING_BYTES = 131072, MISC_OFF = RING_BYTES + 320, LDS_BYTES = 147456;

#define GAS __attribute__((address_space(1)))
typedef unsigned short bf16;
typedef unsigned v4u __attribute__((ext_vector_type(4)));
typedef pg8::f32x4 f32x4;
typedef pg8::bf16x8 bf16x8;
#define LDS_WAIT() asm volatile("s_waitcnt lgkmcnt(0)" ::: "memory")
#define VM_WAIT() asm volatile("s_waitcnt vmcnt(0)" ::: "memory")

typedef __bf16 bf16x2_t __attribute__((ext_vector_type(2)));
__device__ __forceinline__ unsigned pk2(float lo, float hi) { f32x2 v = {lo, hi}; bf16x2_t b = __builtin_convertvector(v, bf16x2_t); return __builtin_bit_cast(unsigned, b); }
__device__ __forceinline__ float bf2f(unsigned short h) { return __uint_as_float((unsigned)h << 16); }
__device__ __forceinline__ unsigned short f2bf1(float f) { return (unsigned short)(pk2(f, 0.f) & 0xffffu); }
__device__ __forceinline__ v4u pack8(f32x4 a, f32x4 b) { v4u w; w.x = pk2(a[0], a[1]); w.y = pk2(a[2], a[3]); w.z = pk2(b[0], b[1]); w.w = pk2(b[2], b[3]); return w; }
template <int CTRL> __device__ __forceinline__ float dpp_mov(float v) { return __int_as_float(__builtin_amdgcn_update_dpp(0, __float_as_int(v), CTRL, 0xF, 0xF, true)); }
__device__ __forceinline__ float sum8(float v) { v += dpp_mov<0xB1>(v); v += dpp_mov<0x4E>(v); v += dpp_mov<0x141>(v); return v; }
__device__ __forceinline__ float sum16(float v) { v = sum8(v); v += dpp_mov<0x140>(v); return v; }
__device__ __forceinline__ float sum_rows(float v) {
    auto a = __builtin_amdgcn_permlane16_swap(__float_as_uint(v), __float_as_uint(v), false, false); v = __uint_as_float(a[0]) + __uint_as_float(a[1]);
    auto b = __builtin_amdgcn_permlane32_swap(__float_as_uint(v), __float_as_uint(v), false, false); return __uint_as_float(b[0]) + __uint_as_float(b[1]); }
__device__ __forceinline__ float wave_sum(float v) { return sum_rows(sum16(v)); }
__device__ __forceinline__ float other_half(float v, int upper) {
    auto b = __builtin_amdgcn_permlane32_swap(__float_as_uint(v), __float_as_uint(v), false, false); return __uint_as_float(upper ? b[0] : b[1]); }
__device__ __forceinline__ float fast_rsqrt(float x) { return __builtin_amdgcn_rsqf(x); }

__device__ __forceinline__ unsigned char* ws_at(unsigned char* base, unsigned long long off) { asm volatile("" : "+s"(off)); return base + off; }
__device__ __forceinline__ int map_src(int map, int n) {
    if (map == 0) {
        const int t = n >> 8, c = n & 255;
        if (t < 3) return t * 256 + c;
        if (t < 6) return 772 + (t - 3) * 256 + c;
        if (t == 6) return 1540 + c;
        if (c < 128) return 1796 + c;
        if (c < 160) return 1924 + (c - 128);
        if (c < 164) return 768 + (c - 160);
        return -1;
    }
    if (map == 2) { const int t = n >> 8, c = n & 255; return c < 128 ? 128 * t + c : DFF + 128 * t + (c - 128); }
    return n;
}
__device__ __forceinline__ void prep_item(const float* W, int Ksrc, int Nsrc, bf16* WT, int Kdst, int map, const float* kscale, LAS float* scr, int kb, int nb, int lane) {
    const int k0 = 64 * kb, n0 = 32 * nb;
    const int sc = map_src(map, n0 + (lane & 31));
    float wv[32];
#pragma unroll
    for (int i = 0; i < 32; ++i) { const int k = k0 + 2 * i + (lane >> 5); wv[i] = (sc >= 0 && k < Ksrc) ? W[(size_t)k * Nsrc + sc] : 0.f; }
    if (kscale) {
#pragma unroll
        for (int i = 0; i < 32; ++i) { const int k = k0 + 2 * i + (lane >> 5); if (k < Ksrc) wv[i] *= kscale[k]; } }
    const float nsc = (map == 3) ? WDN_SC : (map == 2) ? ((((n0 + (lane & 31)) & 255) < 128) ? -1.4426950408889634f : -0.6931471805599453f * ACT_SC) : 1.f;
#pragma unroll
    for (int i = 0; i < 32; ++i) scr[(2 * i + (lane >> 5)) * 33 + (lane & 31)] = wv[i] * nsc;
    LDS_WAIT(); asm volatile("" ::: "memory");
    const int c = lane & 7;
#pragma unroll
    for (int j = 0; j < 4; ++j) { const int n = (lane >> 3) + 8 * j; const LAS float* s = scr + (8 * c) * 33 + n;
        v4u o; o.x = pk2(s[0 * 33], s[1 * 33]); o.y = pk2(s[2 * 33], s[3 * 33]); o.z = pk2(s[4 * 33], s[5 * 33]); o.w = pk2(s[6 * 33], s[7 * 33]);
        *(GAS v4u*)(WT + (size_t)(n0 + n) * Kdst + k0 + 8 * c) = o; }
    LDS_WAIT(); asm volatile("" ::: "memory");
}

__device__ __forceinline__ void prep_item8(const float* W, int Nsrc, unsigned char* WT, int Kdst, float sc, LAS float* scr, int kb, int nb, int lane) {
    const int k0 = 64 * kb, n0 = 32 * nb;
    float wv[32];
#pragma unroll
    for (int i = 0; i < 32; ++i) wv[i] = W[(size_t)(k0 + 2 * i + (lane >> 5)) * Nsrc + n0 + (lane & 31)];
#pragma unroll
    for (int i = 0; i < 32; ++i) scr[(2 * i + (lane >> 5)) * 33 + (lane & 31)] = wv[i] * sc;
    LDS_WAIT(); asm volatile("" ::: "memory");
    const int c = lane & 3;
#pragma unroll
    for (int j = 0; j < 2; ++j) { const int n = (lane >> 2) + 16 * j; const LAS float* s = scr + (16 * c) * 33 + n; v4u o;
#pragma unroll
        for (int q = 0; q < 4; ++q) { int w = __builtin_amdgcn_cvt_pk_fp8_f32(s[(4 * q) * 33], s[(4 * q + 1) * 33], 0, false); w = __builtin_amdgcn_cvt_pk_fp8_f32(s[(4 * q + 2) * 33], s[(4 * q + 3) * 33], w, true); o[q] = (unsigned)w; }
        *(GAS v4u*)(WT + (size_t)(n0 + n) * Kdst + k0 + 16 * c) = o; }
    LDS_WAIT(); asm volatile("" ::: "memory");
}

__device__ __forceinline__ int t5_bucket_dev(int n) {
    if (n < 16) return n;
    int c = 15;
    c += (n >= 16); c += (n >= 19); c += (n >= 21); c += (n >= 24); c += (n >= 27); c += (n >= 31); c += (n >= 35); c += (n >= 40);
    c += (n >= 46); c += (n >= 52); c += (n >= 59); c += (n >= 67); c += (n >= 77); c += (n >= 87); c += (n >= 99); c += (n >= 113);
    return c;
}
__device__ __forceinline__ void sincos_acc(float ang, float& c, float& s) {
    const double a = (double)ang; const double q = __builtin_rint(a * 0.63661977236758134308); const double r = __builtin_fma(-q, 1.57079632679489661923, a) - q * 6.123233995736766e-17;
    const double r2 = r * r;
    double sp = -7.6471637318198164759e-13; sp = sp * r2 + 1.6059043836821614599e-10; sp = sp * r2 - 2.5052108385441718775e-08; sp = sp * r2 + 2.7557319223985890653e-06;
    sp = sp * r2 - 1.9841269841269841270e-04; sp = sp * r2 + 8.3333333333333333333e-03; sp = sp * r2 - 1.6666666666666666667e-01; const double sn = r + r * r2 * sp;
    double cp = 4.7794773323873852974e-14; cp = cp * r2 - 1.1470745597729724714e-11; cp = cp * r2 + 2.0876756987868098979e-09; cp = cp * r2 - 2.7557319223985890653e-07;
    cp = cp * r2 + 2.4801587301587301587e-05; cp = cp * r2 - 1.3888888888888888889e-03; cp = cp * r2 + 4.1666666666666666667e-02; cp = cp * r2 - 0.5; const double cs = 1.0 + r2 * cp;
    const int qi = ((int)q) & 3;
    const double cc = (qi == 0) ? cs : (qi == 1) ? -sn : (qi == 2) ? -cs : sn;
    const double ss = (qi == 0) ? sn : (qi == 1) ? cs : (qi == 2) ? -sn : -cs;
    c = (float)cc; s = (float)ss;
}
__device__ __forceinline__ float rope_invfreq(int i) {
    const float t[16] = {0x1.000000p+0f, 0x1.1feb34p-1f, 0x1.43d136p-2f, 0x1.6c310ep-3f, 0x1.99999ap-4f, 0x1.ccab84p-5f, 0x1.030dc6p-5f, 0x1.235a72p-6f, 0x1.47ae14p-7f, 0x1.708938p-8f, 0x1.9e7c70p-9f, 0x1.d22a50p-10f, 0x1.0624dep-10f, 0x1.26d42cp-11f, 0x1.4b96c0p-12f, 0x1.74eea6p-13f};
    float r = t[0];
#pragma unroll
    for (int k = 1; k < 16; ++k) r = (i == k) ? t[k] : r;
    return r;
}

constexpr int RPI = 4;
__device__ __forceinline__ f32x4 bf4_to_f32(u32x2 w) { f32x4 r; r.x = __uint_as_float(w.x << 16); r.y = __uint_as_float(w.x & 0xffff0000u); r.z = __uint_as_float(w.y << 16); r.w = __uint_as_float(w.y & 0xffff0000u); return r; }
__device__ __forceinline__ float sq4(f32x4 v) { return (v.x * v.x + v.y * v.y) + (v.z * v.z + v.w * v.w); }
__device__ __forceinline__ void prenorm_rows(const float* x, const float* cmod_l  , int ipre, int ish, bf16* H, int gw, int NGW, int lane) {
    for (int ch = gw; ch < MTOK / 32; ch += NGW) {
        const int m0 = ch * 32, b = m0 >> 11;
        const GAS f32x4* prep = (const GAS f32x4*)(cmod_l + ((size_t)b * 6 + ipre) * DM) + lane;
        const GAS f32x4* shp = (const GAS f32x4*)(cmod_l + ((size_t)b * 6 + ish) * DM) + lane;
        f32x4 pre[4], sh[4];
#pragma unroll
        for (int j = 0; j < 4; ++j) { pre[j] = prep[64 * j]; sh[j] = shp[64 * j]; }
#pragma unroll 1
        for (int i = 0; i < 32; i += RPI) {
            f32x4 v[RPI][4];
#pragma unroll
            for (int r = 0; r < RPI; ++r) { const GAS f32x4* xr = (const GAS f32x4*)(x + (size_t)(m0 + i + r) * DM) + lane;
#pragma unroll
                for (int j = 0; j < 4; ++j) v[r][j] = __builtin_nontemporal_load(xr + 64 * j); }
#pragma unroll
            for (int r = 0; r < RPI; ++r) {
                const float rstd = fast_rsqrt(wave_sum((sq4(v[r][0]) + sq4(v[r][1])) + (sq4(v[r][2]) + sq4(v[r][3]))) * (1.f / DM) + RMS_EPS);
                GAS u32x2* o8 = (GAS u32x2*)(H + (size_t)(m0 + i + r) * DM) + lane;
#pragma unroll
                for (int j = 0; j < 4; ++j) { const f32x4 q = v[r][j] * rstd * pre[j] + sh[j]; u32x2 w; w.x = pk2(q.x, q.y); w.y = pk2(q.z, q.w); o8[64 * j] = w; }
            }
        }
    }
}
template <bool XIN_BF, bool XOUT_BF>
__device__ __forceinline__ void post_rows(const void* xin_, void* xout_, const bf16* Y, const float* YSS, float yeps, const float* cmod_l, int ipost,
                                          bool do_pre, const float* cmod_n, int ipre, int ish, bf16* H, int gw, int NGW, int lane) {
    constexpr int RP = XIN_BF ? 8 : RPI;
    const unsigned l8 = (unsigned)lane * 8u, l16 = (unsigned)lane * 16u;
#define LD8(base, j) __builtin_nontemporal_load((const GAS u32x2*)((const GAS char*)(base) + (l8 + (j) * 512u)))
#define LD16(base, j) __builtin_nontemporal_load((const GAS f32x4*)((const GAS char*)(base) + (l16 + (j) * 1024u)))
    for (int ch = gw; ch < MTOK / 32; ch += NGW) {
        const int m0 = ch * 32, b = m0 >> 11;
        const float* pop = cmod_l + ((size_t)b * 6 + ipost) * DM; const float* prep = cmod_n + ((size_t)b * 6 + ipre) * DM; const float* shp = cmod_n + ((size_t)b * 6 + ish) * DM;
        f32x4 po[4], pre[4], sh[4];
#pragma unroll
        for (int j = 0; j < 4; ++j) { po[j] = *(const GAS f32x4*)((const GAS char*)pop + (l16 + j * 1024u)); pre[j] = do_pre ? *(const GAS f32x4*)((const GAS char*)prep + (l16 + j * 1024u)) : po[j]; sh[j] = do_pre ? *(const GAS f32x4*)((const GAS char*)shp + (l16 + j * 1024u)) : po[j]; }
#pragma unroll 1
        for (int i = 0; i < 32; i += RP) {
            const size_t mc = (size_t)(m0 + i);
            f32x4 xf[XIN_BF ? 1 : RP][4]; u32x2 xb[XIN_BF ? RP : 1][4]; u32x2 yw[RP][4]; float rsy[RP];
#pragma unroll
            for (int r = 0; r < RP; ++r) {
                const bf16* yrow = Y + (mc + (r & ~1)) * DM;
                if (XIN_BF) { const bf16* xrow = (const bf16*)xin_ + (mc + (r & ~1)) * DM;
#pragma unroll
                    for (int j = 0; j < 4; ++j) { xb[XIN_BF ? r : 0][j] = LD8(xrow, (r & 1) * 4 + j); yw[r][j] = LD8(yrow, (r & 1) * 4 + j); } }
                else { const float* xrow = (const float*)xin_ + (mc + r) * DM;
#pragma unroll
                    for (int j = 0; j < 4; ++j) { xf[XIN_BF ? 0 : r][j] = LD16(xrow, j); yw[r][j] = LD8(yrow, (r & 1) * 4 + j); } }
                const GAS f32x4* ssp = (const GAS f32x4*)(YSS + (mc + r) * 16);
                const f32x4 s0 = ssp[0], s1 = ssp[1], s2 = ssp[2], s3 = ssp[3];
                rsy[r] = ((s0.x + s0.y) + (s0.z + s0.w)) + ((s1.x + s1.y) + (s1.z + s1.w)) + ((s2.x + s2.y) + (s2.z + s2.w)) + ((s3.x + s3.y) + (s3.z + s3.w)); }
#pragma unroll
            for (int r = 0; r < RP; ++r) {
                const float ry = fast_rsqrt(rsy[r] * (1.f / DM) + yeps);
                float s = 0.f; f32x4 v[4];
#pragma unroll
                for (int j = 0; j < 4; ++j) { const f32x4 xv = XIN_BF ? bf4_to_f32(xb[XIN_BF ? r : 0][j]) : xf[XIN_BF ? 0 : r][j];
                    v[j] = xv + po[j] * bf4_to_f32(yw[r][j]) * ry; s += sq4(v[j]);
                    if (XOUT_BF) { u32x2 w; w.x = pk2(v[j].x, v[j].y); w.y = pk2(v[j].z, v[j].w); __builtin_nontemporal_store(w, (GAS u32x2*)((GAS char*)((bf16*)xout_ + (mc + (r & ~1)) * DM) + (l8 + ((r & 1) * 4 + j) * 512u))); }
                    else __builtin_nontemporal_store(v[j], (GAS f32x4*)((GAS char*)((float*)xout_ + (mc + r) * DM) + (l16 + j * 1024u))); }
                if (do_pre) {
                    const float rstd = fast_rsqrt(wave_sum(s) * (1.f / DM) + RMS_EPS);
                    bf16* hrow = H + (mc + (r & ~1)) * DM;
#pragma unroll
                    for (int j = 0; j < 4; ++j) { const f32x4 q = v[j] * rstd * pre[j] + sh[j]; u32x2 w; w.x = pk2(q.x, q.y); w.y = pk2(q.z, q.w); *(GAS u32x2*)((GAS char*)hrow + (l8 + ((r & 1) * 4 + j) * 512u)) = w; }
                }
            }
        }
    }
#undef LD8
#undef LD16
}
template <int DKP, int NH>
__device__ __forceinline__ unsigned hm_off(int row, int head, int d) { return (unsigned)((((row >> 11) * NH + head) * SEQ + (row & (SEQ - 1))) * DKP + d); }
__device__ __forceinline__ void fox_scan(const float* LOGF, const float* PSUM, bf16* QF, bf16* KF, int gw, int NGW, int lane, LAS float* scr  ) {
    for (int task = gw; task < (MTOK / 256) * 4; task += NGW) {
        const int pm = task >> 2, h = task & 3, b = pm >> 3;
        float carry = 0.f;
        for (int p = b * 8; p < pm; ++p) carry += PSUM[(p * 2) * 4 + h] + PSUM[(p * 2 + 1) * 4 + h];
        const float* src = LOGF + ((size_t)pm * 256 + 4 * lane) * 4 + h;
        float lv[4];
#pragma unroll
        for (int i = 0; i < 4; ++i) lv[i] = src[4 * i];
        scr[lane] = (lv[0] + lv[1]) + (lv[2] + lv[3]); LDS_WAIT(); asm volatile("" ::: "memory");
        float run = carry;
#pragma unroll 16
        for (int i = 0; i < 64; ++i) { const float tv = scr[i]; run += (i < lane) ? tv : 0.f; }
        LDS_WAIT(); asm volatile("" ::: "memory");
        const v4u z = {0u, 0u, 0u, 0u}; v4u q0; q0.x = 0x3f803f80u; q0.y = 0x00003f80u; q0.z = 0u; q0.w = 0u;
        const int row = pm * 256 + 4 * lane;
        const unsigned ko = hm_off<80, 4>(row, h, 64), qo = (unsigned)(row * 320 + h * 80 + 64);
#pragma unroll
        for (int i = 0; i < 4; ++i) {
            run += lv[i];
            const float v = -run;
            const float b1 = bf2f(f2bf1(v)); const float r1 = v - b1; const float b2 = bf2f(f2bf1(r1)); const float r2 = r1 - b2;
            v4u k0; k0.x = pk2(b1, b2); k0.y = pk2(r2, 0.f); k0.z = 0u; k0.w = 0u;
            *(GAS v4u*)(KF + (ko + i * 80u)) = k0; *(GAS v4u*)(KF + (ko + i * 80u + 8u)) = z;
            *(GAS v4u*)(QF + (qo + i * 320u)) = q0; *(GAS v4u*)(QF + (qo + i * 320u + 8u)) = z;
        }
    }
}

__device__ __forceinline__ void glds16(const void* gsrc, unsigned lds_dst) { unsigned keep;
    asm volatile("s_mov_b32 %0, m0\n\ts_mov_b32 m0, %2\n\ts_nop 0\n\tglobal_load_lds_dwordx4 %1, off\n\ts_mov_b32 m0, %0" : "=&s"(keep) : "v"(gsrc), "s"(lds_dst) : "memory"); }
__device__ __forceinline__ void build_kmf(const float* KMP, bf16* KMF, int gw, int NGW, int lane) {
    const int r32 = lane & 31, hi = lane >> 5;
    for (int t4 = gw; t4 < NB * 4 * 4; t4 += NGW) { const int task = t4 >> 2, d0 = t4 & 3, b = task >> 2, h = task & 3;
        float v[8];
#pragma unroll
        for (int j = 0; j < 8; ++j) { v[j] = 0.f; if (r32 < 8) { const float* p = KMP + ((size_t)(b * 8 + r32) * 2) * 256 + h * 64 + 16 * d0 + 8 * hi + j; v[j] = p[0] + p[256]; } }
        v4u wh, wl; float l[8], hh[8];
#pragma unroll
        for (int j = 0; j < 8; ++j) { hh[j] = bf2f(f2bf1(v[j])); l[j] = v[j] - hh[j]; }
        wh.x = pk2(hh[0], hh[1]); wh.y = pk2(hh[2], hh[3]); wh.z = pk2(hh[4], hh[5]); wh.w = pk2(hh[6], hh[7]);
        wl.x = pk2(l[0], l[1]); wl.y = pk2(l[2], l[3]); wl.z = pk2(l[4], l[5]); wl.w = pk2(l[6], l[7]);
        *(GAS v4u*)(KMF + (((size_t)task * 2 + 0) * 4 + d0) * 512 + lane * 8) = wh;
        *(GAS v4u*)(KMF + (((size_t)task * 2 + 1) * 4 + d0) * 512 + lane * 8) = wl;
    }
}
using pg8::Unit;
template <int HEADPITCH>
__device__ __forceinline__ void store_bf16_tile(const f32x4 (&acc)[2][2][4][2], bf16* base, int pitch, int row0, int ct0, float sc) {
#pragma unroll
    for (int ai = 0; ai < 2; ++ai)
#pragma unroll
        for (int m = 0; m < 4; ++m) { bf16* rowp = base + (size_t)(row0 + ai * 128 + m * 16) * pitch;
#pragma unroll
            for (int bj = 0; bj < 2; ++bj) { const int ct = bj * 128 + ct0; const int col = HEADPITCH ? (ct >> 6) * HEADPITCH + (ct & 63) : ct;
                *(GAS v4u*)(rowp + col) = pack8(acc[ai][bj][m][0] * sc, acc[ai][bj][m][1] * sc); } }
}
struct EpiInproj {
    static constexpr bool PERM = true, AFTER_DRAIN = false, KSCALE = false;
    unsigned char* ws; const float* bfg;
    __device__ __forceinline__ void operator()(const f32x4 (&acc)[2][2][4][2], const Unit& u, int wr, int wc, int fr, int fq) const {
        unsigned char* wsl = ws; asm volatile("" : "+s"(wsl));
        bf16* const QF = (bf16*)ws_at(wsl, WS_QF); bf16* const KF = (bf16*)ws_at(wsl, WS_KF); bf16* const VF = (bf16*)ws_at(wsl, WS_VF); bf16* const QM = (bf16*)ws_at(wsl, WS_QM); bf16* const KM = (bf16*)ws_at(wsl, WS_KM);
        bf16* const VM = (bf16*)ws_at(wsl, WS_VM); bf16* const CQ = (bf16*)ws_at(wsl, WS_CQ); bf16* const T7 = (bf16*)ws_at(wsl, WS_T7); bf16* const KR = (bf16*)ws_at(wsl, WS_KR);
        float* const KMP = (float*)ws_at(wsl, WS_KMP); float* const CQSS = (float*)ws_at(wsl, WS_CQSS); float* const CKVSS = (float*)ws_at(wsl, WS_CKVSS); float* const LOGF = (float*)ws_at(wsl, WS_LOGF);
        const f32x2* const ROPE = (const f32x2*)ws_at(wsl, WS_ROPE);
        const int row0 = u.pm * 256 + wr * 64 + fr, ct0 = wc * 32 + 8 * fq;
        const int pn = u.pn;
        if (pn == 0) { store_bf16_tile<80>(acc, QF, 320, row0, ct0, C2_64); return; }
        if (pn == 1) {
            const int hd0 = ct0 >> 6, d = ct0 & 63;
#pragma unroll
            for (int ai = 0; ai < 2; ++ai)
#pragma unroll
                for (int m = 0; m < 4; ++m) { const unsigned off = hm_off<80, 4>(row0 + ai * 128 + m * 16, hd0, d);
                    *(GAS v4u*)(KF + off) = pack8(acc[ai][0][m][0], acc[ai][0][m][1]); *(GAS v4u*)(KF + (off + 2u * SEQ * 80u)) = pack8(acc[ai][1][m][0], acc[ai][1][m][1]);
                    if (m & 1) asm volatile("" ::: "memory"); }
            return; }
        if (pn == 2) { store_bf16_tile<0>(acc, VF, 256, row0, ct0, 1.f); return; }
        if (pn == 3) { store_bf16_tile<0>(acc, QM, 256, row0, ct0, C2_64); return; }
        if (pn == 5) { store_bf16_tile<0>(acc, VM, 256, row0, ct0, 1.f); return; }
        if (pn == 4) {
            store_bf16_tile<0>(acc, KM, 256, row0, ct0, 1.f);
#pragma unroll
            for (int bj = 0; bj < 2; ++bj)
#pragma unroll
                for (int n = 0; n < 2; ++n) { f32x4 s = {0.f, 0.f, 0.f, 0.f};
#pragma unroll
                    for (int ai = 0; ai < 2; ++ai)
#pragma unroll
                        for (int m = 0; m < 4; ++m) s += acc[ai][bj][m][n];
                    s.x = sum16(s.x); s.y = sum16(s.y); s.z = sum16(s.z); s.w = sum16(s.w);
                    if (fr == 0) *(GAS f32x4*)(KMP + ((size_t)u.pm * 2 + wr) * 256 + bj * 128 + ct0 + 4 * n) = s; }
            return;
        }
        if (pn == 6) {
            store_bf16_tile<0>(acc, CQ, 256, row0, ct0, 1.f);
#pragma unroll
            for (int ai = 0; ai < 2; ++ai)
#pragma unroll
                for (int m = 0; m < 4; ++m) { float s = 0.f;
#pragma unroll
                    for (int bj = 0; bj < 2; ++bj)
#pragma unroll
                        for (int n = 0; n < 2; ++n) { const f32x4 x = acc[ai][bj][m][n]; s += (x.x * x.x + x.y * x.y) + (x.z * x.z + x.w * x.w); }
                    s = sum_rows(s);
                    if (fq == 0) CQSS[(size_t)(row0 + ai * 128 + m * 16) * 4 + wc] = s; }
            return;
        }
#pragma unroll
        for (int ai = 0; ai < 2; ++ai)
#pragma unroll
            for (int m = 0; m < 4; ++m) *(GAS v4u*)(T7 + (unsigned)((row0 + ai * 128 + m * 16) * 128 + ct0)) = pack8(acc[ai][0][m][0], acc[ai][0][m][1]);
        f32x4 fsum = {0.f, 0.f, 0.f, 0.f};
#pragma unroll
        for (int ai = 0; ai < 2; ++ai)
#pragma unroll
            for (int m = 0; m < 4; ++m) { const int row = row0 + ai * 128 + m * 16; float s = 0.f;
#pragma unroll
                for (int n = 0; n < 2; ++n) { const f32x4 x = acc[ai][0][m][n]; s += (x.x * x.x + x.y * x.y) + (x.z * x.z + x.w * x.w); }
                s = sum_rows(s);
                if (fq == 0) CKVSS[(size_t)row * 4 + wc] = s;
                if (wc == 0) {
                    const int pos = row & (SEQ - 1); f32x4 o[2];
#pragma unroll
                    for (int n = 0; n < 2; ++n) { const f32x4 x = acc[ai][1][m][n]; f32x4 p;
                        p.x = other_half(x.x, fq >> 1); p.y = other_half(x.y, fq >> 1); p.z = other_half(x.z, fq >> 1); p.w = other_half(x.w, fq >> 1);
                        const int d = 8 * fq + 4 * n; const float sg = (fq < 2) ? -1.f : 1.f;
                        const GAS f32x2* cs = (const GAS f32x2*)ROPE + pos * 16 + (d & 15);
                        const f32x2 c0 = cs[0], c1 = cs[1], c2 = cs[2], c3 = cs[3];
                        o[n].x = x.x * c0.x + sg * p.x * c0.y; o[n].y = x.y * c1.x + sg * p.y * c1.y; o[n].z = x.z * c2.x + sg * p.z * c2.y; o[n].w = x.w * c3.x + sg * p.w * c3.y; }
                    const v4u w = pack8(o[0], o[1]);
                    *(GAS v4u*)(KR + (unsigned)(row * 32 + 8 * fq)) = w;
                }
                if (wc == 1 && fq == 0) {
                    const f32x4 x = acc[ai][1][m][0]; f32x4 r;
#pragma unroll
                    for (int j = 0; j < 4; ++j) { const float z = x[j] + bfg[j]; const float az = __builtin_fabsf(z);
                        r[j] = __builtin_fminf(z, 0.f) * LOG2E - __builtin_amdgcn_logf(1.f + __builtin_amdgcn_exp2f(-az * LOG2E)); }
                    *(GAS f32x4*)(LOGF + (size_t)row * 4) = r; fsum += r;
                }
            }
        if (wc == 1) { fsum.x = sum16(fsum.x); fsum.y = sum16(fsum.y); fsum.z = sum16(fsum.z); fsum.w = sum16(fsum.w);
            if (fq == 0 && fr == 0) *(GAS f32x4*)((float*)ws_at(wsl, WS_PSUM) + ((size_t)u.pm * 2 + wr) * 4) = fsum; }
    }
};
struct EpiQup {
    static constexpr bool PERM = true, AFTER_DRAIN = false, KSCALE = false;
    bf16* QC; const float* CQSS; const f32x2* ROPE;
    __device__ __forceinline__ void operator()(const f32x4 (&acc)[2][2][4][2], const Unit& u, int wr, int wc, int fr, int fq) const {
        const int row0 = u.pm * 256 + wr * 64 + fr;
        f32x4 ss[2][4]; float rstd[2][4];
#pragma unroll
        for (int ai = 0; ai < 2; ++ai)
#pragma unroll
            for (int m = 0; m < 4; ++m) ss[ai][m] = *(const GAS f32x4*)(CQSS + (size_t)(row0 + ai * 128 + m * 16) * 4);
#pragma unroll
        for (int ai = 0; ai < 2; ++ai)
#pragma unroll
            for (int m = 0; m < 4; ++m) rstd[ai][m] = fast_rsqrt(((ss[ai][m].x + ss[ai][m].y) + (ss[ai][m].z + ss[ai][m].w)) * (1.f / 256.f) + RMS_EPS);
        const int rbj = ((8 * u.pn + wc) % 3 == 2) ? 0 : (((8 * u.pn + 4 + wc) % 3 == 2) ? 1 : -1);
        const float sg = (fq < 2) ? -1.f : 1.f;
#pragma unroll
        for (int ai = 0; ai < 2; ++ai)
#pragma unroll
            for (int mp = 0; mp < 4; mp += 2) {
                f32x4 cs[2][4];
                if (rbj >= 0) {
#pragma unroll
                    for (int m2 = 0; m2 < 2; ++m2) { const int pos = (row0 + ai * 128 + (mp + m2) * 16) & (SEQ - 1); const GAS f32x4* cp = (const GAS f32x4*)((const GAS f32x2*)ROPE + pos * 16 + 8 * (fq & 1));
#pragma unroll
                        for (int q = 0; q < 4; ++q) cs[m2][q] = cp[q]; }
                }
#pragma unroll
                for (int m2 = 0; m2 < 2; ++m2) { const int m = mp + m2; const int row = row0 + ai * 128 + m * 16; const float rs = rstd[ai][m];
#pragma unroll
                    for (int bj = 0; bj < 2; ++bj) { f32x4 o[2];
#pragma unroll
                        for (int n = 0; n < 2; ++n) { const f32x4 x = acc[ai][bj][m][n] * rs;
                            if (bj == rbj) { f32x4 p; p.x = other_half(x.x, fq >> 1); p.y = other_half(x.y, fq >> 1); p.z = other_half(x.z, fq >> 1); p.w = other_half(x.w, fq >> 1);
                                const f32x4 c01 = cs[m2][2 * n], c23 = cs[m2][2 * n + 1];
                                o[n].x = x.x * c01.x + sg * p.x * c01.y; o[n].y = x.y * c01.z + sg * p.y * c01.w; o[n].z = x.z * c23.x + sg * p.z * c23.y; o[n].w = x.w * c23.z + sg * p.w * c23.w;
                            } else o[n] = x; }
                        *(GAS v4u*)(QC + (size_t)row * 768 + u.pn * 256 + bj * 128 + wc * 32 + 8 * fq) = pack8(o[0] * C2_96, o[1] * C2_96); } }
                asm volatile("" ::: "memory");
            }
    }
};
struct EpiKVup {
    static constexpr bool PERM = true, AFTER_DRAIN = false, KSCALE = false;
    bf16 *KC, *VC; const float* CKVSS;
    __device__ __forceinline__ void operator()(const f32x4 (&acc)[2][2][4][2], const Unit& u, int wr, int wc, int fr, int fq) const {
        const int row0 = u.pm * 256 + wr * 64 + fr;
        f32x4 ss[2][4]; float rstd[2][4];
#pragma unroll
        for (int ai = 0; ai < 2; ++ai)
#pragma unroll
            for (int m = 0; m < 4; ++m) ss[ai][m] = *(const GAS f32x4*)(CKVSS + (size_t)(row0 + ai * 128 + m * 16) * 4);
#pragma unroll
        for (int ai = 0; ai < 2; ++ai)
#pragma unroll
            for (int m = 0; m < 4; ++m) rstd[ai][m] = fast_rsqrt(((ss[ai][m].x + ss[ai][m].y) + (ss[ai][m].z + ss[ai][m].w)) * (1.f / 128.f) + RMS_EPS);
#pragma unroll
        for (int ai = 0; ai < 2; ++ai)
#pragma unroll
            for (int m = 0; m < 4; ++m) { const int row = row0 + ai * 128 + m * 16; const float rs = rstd[ai][m];
#pragma unroll
                for (int bj = 0; bj < 2; ++bj) { const int head = 2 * u.pn + bj, within = wc * 32 + 8 * fq;
                    const v4u w = pack8(acc[ai][bj][m][0] * rs, acc[ai][bj][m][1] * rs);
                    if (wc < 2) *(GAS v4u*)(KC + hm_off<64, 8>(row, head, within)) = w;
                    else *(GAS v4u*)(VC + (size_t)row * 512 + head * 64 + (within - 64)) = w; } }
    }
};
struct EpiY {
    static constexpr bool PERM = true, AFTER_DRAIN = false, KSCALE = false;
    bf16* Y; float* YSS;
    __device__ __forceinline__ void operator()(const f32x4 (&acc)[2][2][4][2], const Unit& u, int wr, int wc, int fr, int fq) const {
        asm volatile("" : "+v"(fr), "+v"(fq));
        const int row0 = u.pm * 256 + wr * 64 + fr, ct0 = wc * 32 + 8 * fq;
#pragma unroll
        for (int ai = 0; ai < 2; ++ai)
#pragma unroll
            for (int m = 0; m < 4; ++m) { const int row = row0 + ai * 128 + m * 16; float s = 0.f;
#pragma unroll
                for (int bj = 0; bj < 2; ++bj) {
#pragma unroll
                    for (int n = 0; n < 2; ++n) { const f32x4 x = acc[ai][bj][m][n]; s += (x.x * x.x + x.y * x.y) + (x.z * x.z + x.w * x.w); }
                    *(GAS v4u*)(Y + (unsigned)(row * DM + u.pn * 256 + bj * 128 + ct0)) = pack8(acc[ai][bj][m][0], acc[ai][bj][m][1]); }
                s = sum_rows(s);
                if (fq == 0) YSS[(unsigned)(row * 16 + u.pn * 4 + wc)] = s; }
    }
};
struct EpiYks {
    static constexpr bool PERM = true, AFTER_DRAIN = false, KSCALE = true;
    bf16* Y; float* YSS; const float* F; LAS float* tab;
    __device__ __forceinline__ void prep(const Unit& u, int par, int wid, int lane) const {
        if (wid < 4) glds16(F + ((size_t)u.pm * 256 + wid * 64 + lane) * 4, (unsigned)__builtin_amdgcn_readfirstlane((unsigned)(uintptr_t)tab + par * 4096 + wid * 1024)); }
    __device__ __forceinline__ void kscale(f32x4 (&acc)[2][2][4][2], int par, int which, int wr, int fr) const {
#pragma unroll
        for (int ai = 0; ai < 2; ++ai)
#pragma unroll
            for (int m = 0; m < 4; ++m) { const float s = tab[par * 1024 + (ai * 128 + wr * 64 + m * 16 + fr) * 4 + which];
#pragma unroll
                for (int bj = 0; bj < 2; ++bj)
#pragma unroll
                    for (int n = 0; n < 2; ++n) acc[ai][bj][m][n] *= s; } }
    __device__ __forceinline__ void operator()(const f32x4 (&acc)[2][2][4][2], const Unit& u, int wr, int wc, int fr, int fq) const {
        const int row0 = u.pm * 256 + wr * 64 + fr, ct0 = wc * 32 + 8 * fq;
#pragma unroll
        for (int ai = 0; ai < 2; ++ai)
#pragma unroll
            for (int m = 0; m < 4; ++m) { const int row = row0 + ai * 128 + m * 16; float s = 0.f;
#pragma unroll
                for (int bj = 0; bj < 2; ++bj) {
#pragma unroll
                    for (int n = 0; n < 2; ++n) { const f32x4 x = acc[ai][bj][m][n]; s += (x.x * x.x + x.y * x.y) + (x.z * x.z + x.w * x.w); }
                    *(GAS v4u*)(Y + (size_t)row * DM + u.pn * 256 + bj * 128 + ct0) = pack8(acc[ai][bj][m][0], acc[ai][bj][m][1]); }
                s = sum_rows(s);
                if (fq == 0) YSS[(size_t)row * 16 + u.pn * 4 + wc] = s; }
    }
};
struct EpiSwiglu {
    static constexpr bool PERM = true, AFTER_DRAIN = false, KSCALE = false;
    bf16* ACT; unsigned char* ACT8; int pm8;
    __device__ __forceinline__ void operator()(const f32x4 (&acc)[2][2][4][2], const Unit& u, int wr, int wc, int fr, int fq) const {
        const int row0 = u.pm * 256 + wr * 64 + fr, ct0 = wc * 32 + 8 * fq; const bool f8 = (PM8_L0 == 256 && PM8_L1 == 256) || u.pm < pm8;
#pragma unroll
        for (int ai = 0; ai < 2; ++ai)
#pragma unroll
            for (int m = 0; m < 4; ++m) { const int row = row0 + ai * 128 + m * 16; f32x4 o[2];
#pragma unroll
                for (int n = 0; n < 2; ++n) { const f32x4 g = acc[ai][0][m][n], up = acc[ai][1][m][n];
#pragma unroll
                    for (int j = 0; j < 4; ++j) o[n][j] = g[j] * up[j] * __builtin_amdgcn_rcpf(1.f + __builtin_amdgcn_exp2f(g[j])); }
                if (f8) { u32x2 w; { int t = __builtin_amdgcn_cvt_pk_fp8_f32(o[0][0], o[0][1], 0, false); t = __builtin_amdgcn_cvt_pk_fp8_f32(o[0][2], o[0][3], t, true); w.x = (unsigned)t; }
                    { int t = __builtin_amdgcn_cvt_pk_fp8_f32(o[1][0], o[1][1], 0, false); t = __builtin_amdgcn_cvt_pk_fp8_f32(o[1][2], o[1][3], t, true); w.y = (unsigned)t; }
                    *(GAS u32x2*)(ACT8 + (size_t)row * DFF + u.pn * 128 + ct0) = w; }
                else __builtin_nontemporal_store(pack8(o[0], o[1]), (GAS v4u*)(ACT + (size_t)row * DFF + u.pn * 128 + ct0)); }
    }
};

__device__ __forceinline__ int crow(int r, int hi) { return (r & 3) + 8 * (r >> 2) + 4 * hi; }
typedef short v4i16_t __attribute__((ext_vector_type(4)));
__device__ __forceinline__ float half_max(float m) { auto rr = __builtin_amdgcn_permlane32_swap(__float_as_uint(m), __float_as_uint(m), false, false); return __builtin_fmaxf(__uint_as_float(rr[0]), __uint_as_float(rr[1])); }
__device__ __forceinline__ float half_sum(float m) { auto rr = __builtin_amdgcn_permlane32_swap(__float_as_uint(m), __float_as_uint(m), false, false); return __uint_as_float(rr[0]) + __uint_as_float(rr[1]); }
namespace att {
__device__ __forceinline__ void glds16s(unsigned voff, const void* sbase, unsigned lds_dst) { unsigned keep;
    asm volatile("s_mov_b32 %0, m0\n\ts_mov_b32 m0, %2\n\ts_nop 0\n\tglobal_load_lds_dwordx4 %1, %3\n\ts_mov_b32 m0, %0" : "=&s"(keep) : "v"(voff), "s"(lds_dst), "s"(sbase) : "memory"); }
template <class T> __device__ __forceinline__ T* uniform_ptr(T* p) { const unsigned long long v = (unsigned long long)p;
    const unsigned lo = (unsigned)__builtin_amdgcn_readfirstlane((int)(unsigned)v), hi = (unsigned)__builtin_amdgcn_readfirstlane((int)(unsigned)(v >> 32)); return (T*)(((unsigned long long)hi << 32) | lo); }
typedef short s16x4 __attribute__((ext_vector_type(4)));
typedef unsigned u32x4_t __attribute__((ext_vector_type(4)));
typedef __attribute__((address_space(3))) const char* lds_cptr;
#define SBAR() __builtin_amdgcn_sched_barrier(0)
__device__ __forceinline__ float max3f(float a, float b, float c) { float r; asm("v_max3_f32 %0, %1, %2, %3" : "=v"(r) : "v"(a), "v"(b), "v"(c)); return r; }
__device__ __forceinline__ float max2f(float a, float b) { float r; asm("v_max_f32_e32 %0, %1, %2" : "=v"(r) : "v"(a), "v"(b)); return r; }
__device__ __forceinline__ float fadd_s(float a, float b) { float r; asm("v_add_f32_e32 %0, %1, %2" : "=v"(r) : "v"(a), "v"(b)); return r; }
__device__ __forceinline__ float fsub_s(float a, float b) { float r; asm("v_sub_f32_e32 %0, %1, %2" : "=v"(r) : "v"(a), "v"(b)); return r; }
#define WAIT_BAR(N) asm volatile("s_waitcnt vmcnt(" #N ") lgkmcnt(0)\n\ts_barrier" ::: "memory")
#define WB_K2V1() do { if (k2) WAIT_BAR(5); else WAIT_BAR(3); } while (0)
#define WB_K1V1() do { if (k2) WAIT_BAR(3); else WAIT_BAR(2); } while (0)
#define WB_K1V2() do { if (k2) WAIT_BAR(4); else WAIT_BAR(3); } while (0)
#define WB_K2V2() do { if (k2) WAIT_BAR(6); else WAIT_BAR(4); } while (0)
#define WB_K0V1() WAIT_BAR(1)
#define WB_0() WAIT_BAR(0)
__device__ __forceinline__ void cmask(f32x16& p0, f32x16& p1, int jb, int qrel, int hi) {
    const float NEG = -INFINITY; const int kb = 64 * jb + 4 * hi;
#pragma unroll
    for (int r = 0; r < 16; ++r) { const int kv = kb + (r & 3) + 8 * (r >> 2); if (kv > qrel) p0[r] = NEG; if (kv + 32 > qrel) p1[r] = NEG; }
}
template <int KD>
__device__ __forceinline__ void qkt(f32x16& p0, f32x16& p1, lds_cptr kb, const bf16x8* qr, const f32x16& negm) {
#pragma unroll
    for (int d0 = 0; d0 < KD; ++d0) {
        const bf16x8 b0 = *(const LAS bf16x8*)(kb + d0 * 2048);
        const bf16x8 b1 = *(const LAS bf16x8*)(kb + d0 * 2048 + 512);
        if (d0 == 0) { p0 = __builtin_amdgcn_mfma_f32_32x32x16_bf16(b0, qr[0], negm, 0, 0, 0); p1 = __builtin_amdgcn_mfma_f32_32x32x16_bf16(b1, qr[0], negm, 0, 0, 0); }
        else { p0 = __builtin_amdgcn_mfma_f32_32x32x16_bf16(b0, qr[d0], p0, 0, 0, 0); p1 = __builtin_amdgcn_mfma_f32_32x32x16_bf16(b1, qr[d0], p1, 0, 0, 0); } }
}
__device__ __forceinline__ void kload2(bf16x8* kf, lds_cptr kp, int j) { kf[2 * j] = *(const LAS bf16x8*)(kp + j * 2048); kf[2 * j + 1] = *(const LAS bf16x8*)(kp + j * 2048 + 512); }
__device__ __forceinline__ s16x4 vtr(lds_cptr p) { return __builtin_bit_cast(s16x4, __builtin_amdgcn_ds_read_tr16_b64_v4i16((LAS v4i16_t*)p)); }
__device__ __forceinline__ float rowmax(const f32x16& p0, const f32x16& p1) {
    float a = max3f(p0[0], p0[1], p1[0]), b = max3f(p0[2], p0[3], p1[1]); a = max3f(a, p1[2], p1[3]);
#pragma unroll
    for (int r = 4; r < 16; r += 4) { a = max3f(a, p0[r], p0[r + 1]); b = max3f(b, p0[r + 2], p0[r + 3]); a = max3f(a, p1[r], p1[r + 1]); b = max3f(b, p1[r + 2], p1[r + 3]); }
    const float m = max2f(a, b);
    auto rr = __builtin_amdgcn_permlane32_swap(__float_as_uint(m), __float_as_uint(m), false, false);
    return max2f(__uint_as_float(rr[0]), __uint_as_float(rr[1]));
}
__device__ __forceinline__ void pv(f32x16* o, int vb, bf16x8 pa0, bf16x8 pa1, bf16x8 pa2, bf16x8 pa3) {
#pragma unroll
    for (int d0 = 0; d0 < 2; ++d0) { s16x4 lo[4], hi[4];
#pragma unroll
        for (int ks = 0; ks < 4; ++ks) {
            asm volatile("ds_read_b64_tr_b16 %0,%1 offset:%c2" : "=&v"(lo[ks]) : "v"(vb), "i"(d0 * 4096 + ks * 1024) : "memory");
            asm volatile("ds_read_b64_tr_b16 %0,%1 offset:%c2" : "=&v"(hi[ks]) : "v"(vb), "i"(d0 * 4096 + ks * 1024 + 512) : "memory"); }
        asm volatile("s_waitcnt lgkmcnt(0)" ::: "memory"); SBAR();
#define PK(k) (bf16x8){lo[k][0], lo[k][1], lo[k][2], lo[k][3], hi[k][0], hi[k][1], hi[k][2], hi[k][3]}
        o[d0] = __builtin_amdgcn_mfma_f32_32x32x16_bf16(pa0, PK(0), o[d0], 0, 0, 0);
        o[d0] = __builtin_amdgcn_mfma_f32_32x32x16_bf16(pa1, PK(1), o[d0], 0, 0, 0);
        o[d0] = __builtin_amdgcn_mfma_f32_32x32x16_bf16(pa2, PK(2), o[d0], 0, 0, 0);
        o[d0] = __builtin_amdgcn_mfma_f32_32x32x16_bf16(pa3, PK(3), o[d0], 0, 0, 0);
#undef PK
    }
}
template <int KD> struct Lay { static constexpr int KSLOT = KD * 2048, VSLOT = 8192, LDS_K = 0, LDS_V = 3 * KSLOT, LDS_WS = LDS_V + 4 * VSLOT, LDS_TB = LDS_WS + 2048, LDS_OST = LDS_TB + 1024, LDS_END = LDS_OST + 8 * 4096; };

template <int KD, int MODE, int THRL, int KBS  , int KPITCH>
__device__ __forceinline__ void attn_unit_t(const bf16* Q, int qpitch, const bf16* __restrict__ K, const bf16* __restrict__ V, int vpitch, bf16* O,
                                            int b, int qb, LAS unsigned char* lds, const float* kmp_b, float* oss, bool pre, int nb, int nqb, const bf16* KR = nullptr  ) {
    constexpr int kpitch = KPITCH;
    typedef Lay<KD> LY; constexpr int KSLOT = LY::KSLOT, SLOTB = LY::VSLOT, LDS_K = LY::LDS_K, LDS_V = LY::LDS_V;
    static_assert(LY::LDS_END <= RING_BYTES, "attention LDS map");
    int tid = threadIdx.x; asm volatile("" : "+v"(tid));
    const int lane = tid & 63, r32 = lane & 31, hi = lane >> 5; const int wid = __builtin_amdgcn_readfirstlane(tid >> 6);
    const long rowbase = (long)b * SEQ; const int q0 = qb * 256;
    const bf16* Qw = Q + (rowbase + q0 + wid * 32) * qpitch;
    const bf16* Kh = K + (long)b * KBS, *Vh = V + rowbase * vpitch;
    const unsigned lds0 = (unsigned)(uintptr_t)lds;
    LAS float* wsf = (LAS float*)(lds + LY::LDS_WS) + wid * 64;
    const bool k2 = (wid + 8 < 2 * KD);
    const bf16* ksrc = Kh + (long)lane * kpitch + wid * 8;
    const bf16* vsrc = Vh + (long)(16 * (wid & 3) + (lane >> 2)) * vpitch + (wid >> 2) * 32 + (lane & 3) * 8;
    const unsigned kdst = lds0 + LDS_K + wid * 1024, vdst = lds0 + LDS_V + wid * 1024;
    const bf16* krh = (KD == 6) ? uniform_ptr(KR + rowbase * 32) : nullptr;
#define KO(x) (((x) >> 2) * KD)
#define DMA_K2(kbase_, krb_, t, slot) do { const unsigned kd_ = (unsigned)__builtin_amdgcn_readfirstlane(kdst + KO(slot)); glds16((kbase_) + (long)(t) * 64 * kpitch, kd_); \
        if (k2) { if constexpr (KD == 6) glds16s((unsigned)(lane * 64 + wid * 16) + (unsigned)(t) * 4096u, krb_, kd_ + 8192); else glds16((kbase_) + 64 + (long)(t) * 64 * kpitch, kd_ + 8192); } } while (0)
#define DMA_K(t, slot) DMA_K2(ksrc, krh, t, slot)
#define DMA_V(t, slot) glds16(vsrc + (long)(t) * 64 * vpitch, (unsigned)__builtin_amdgcn_readfirstlane(vdst + (slot)))
    const lds_cptr shm3 = (lds_cptr)lds;
    const lds_cptr kp0 = shm3 + LDS_K + hi * 1024 + r32 * 16;
    const lds_cptr vp0 = shm3 + LDS_V + ((lane >> 4) & 1) * 32 + (lane & 3) * 8 + (4 * hi + ((lane & 15) >> 2)) * 64;
    const int vb0 = (int)(lds0 + LDS_V) + ((lane >> 4) & 1) * 32 + (lane & 3) * 8 + (4 * hi + ((lane & 15) >> 2)) * 64;
    bf16x8 kf[2 * KD];
    const int NT = 4 * (qb + 1);
    if (!pre) { DMA_K(0, 0); DMA_V(0, 0); DMA_K(1, SLOTB); DMA_V(1, SLOTB); }
    bf16x8 qr[KD];
#pragma unroll
    for (int d0 = 0; d0 < KD; ++d0) qr[d0] = *(const GAS bf16x8*)(Qw + (long)r32 * qpitch + d0 * 16 + hi * 8);
    const int qrel = wid * 32 + r32, qpos = q0 + qrel;
    unsigned selmask = 0xffu;
    if (MODE == 1 && qb >= 4) {
        const bf16* kmf = (const bf16*)kmp_b; f32x16 ga = f32x16{};
#pragma unroll
        for (int hl = 0; hl < 2; ++hl)
#pragma unroll
            for (int d0 = 0; d0 < 4; ++d0) { const bf16x8 a = *(const GAS bf16x8*)(kmf + ((hl * 4 + d0) * 64 + lane) * 8); ga = __builtin_amdgcn_mfma_f32_32x32x16_bf16(a, qr[d0], ga, 0, 0, 0); }
        float g[8];
#pragma unroll
        for (int j = 0; j < 4; ++j) { auto rr = __builtin_amdgcn_permlane32_swap(__float_as_uint(ga[j]), __float_as_uint(ga[j]), false, false); g[j] = __uint_as_float(rr[0]); g[4 + j] = __uint_as_float(rr[1]); }
#pragma unroll
        for (int n = 0; n < 7; ++n) if (n >= qb) g[n] = -INFINITY;
        selmask = 0u;
#pragma unroll
        for (int n = 0; n < 7; ++n) { int rank = 0;
#pragma unroll
            for (int mm = 0; mm < 7; ++mm) if (mm != n) rank += (g[mm] > g[n] || (g[mm] == g[n] && mm < n)) ? 1 : 0;
            if (n < qb && rank < 3) selmask |= 1u << n; }
    }
#define SELNEG(blk_) ((MODE != 1 || (blk_) >= qb || ((selmask >> (blk_)) & 1u)) ? 0.f : -INFINITY)
    float selneg = SELNEG(0);
    float mhat = 0.f, l_reg = 0.f; f32x16 o[2]; o[0] = f32x16{}; o[1] = f32x16{}; f32x16 negm;
#pragma unroll
    for (int r = 0; r < 16; ++r) negm[r] = selneg;
    asm volatile("" : "+v"(negm));
    const LAS float* TBl = (const LAS float*)(lds + LY::LDS_TB);
#define TBIAS(P0, P1, t) do { int D0_ = qpos - 64 * (t) - 4 * hi; D0_ = D0_ < -1 ? -1 : (D0_ > 191 ? 191 : D0_); const LAS float* rb_ = TBl + (191 - D0_); \
        _Pragma("unroll") for (int r = 0; r < 16; ++r) { const int c_ = (r & 3) + 8 * (r >> 2); P0[r] += rb_[c_]; P1[r] += rb_[c_ + 32]; } } while (0)
#define CMASK(P0, P1, t) do { if (MODE == 0) { const int jb_ = (t) - (NT - 4); if (jb_ >= 0) cmask(P0, P1, jb_, qrel, hi); } else { if ((t) + 6 >= NT) TBIAS(P0, P1, t); } } while (0)
    bool resc = false;
#define START(P0, P1) do { const float rm = rowmax(P0, P1); resc = false; \
    { const float dl = __builtin_fmaxf(rm, 0.f); mhat = fadd_s(mhat, dl); \
      _Pragma("unroll") for (int r = 0; r < 16; ++r) { P0[r] = fsub_s(P0[r], dl); P1[r] = fsub_s(P1[r], dl); } \
      _Pragma("unroll") for (int r = 0; r < 16; ++r) negm[r] = selneg - mhat; asm volatile("" : "+v"(negm)); } \
    _Pragma("unroll") for (int r = 0; r < 16; ++r) P0[r] = __builtin_amdgcn_exp2f(P0[r]); } while (0)
#define RESC() do { if (resc) { asm volatile("s_waitcnt lgkmcnt(0)" ::: "memory"); \
      _Pragma("unroll") for (int d_ = 0; d_ < 2; ++d_) _Pragma("unroll") for (int r = 0; r < 16; ++r) o[d_][r] *= wsf[crow(r, hi)]; } } while (0)
#define NEXTBLK(t) do { if (MODE == 1 && (((t) + 1) & 3) == 0) { selneg = SELNEG(((t) + 1) >> 2); _Pragma("unroll") for (int r = 0; r < 16; ++r) negm[r] = selneg - mhat; asm volatile("" : "+v"(negm)); } } while (0)
    f32x16 pA0, pA1, pB0, pB1;
    int sl_cur = 0, sl_next = SLOTB;
    int vs_prev = 0, vs_cur = 0, vs_next = SLOTB, vs_nn = 2 * SLOTB;
#define ROT() do { sl_cur = sl_next; sl_next = (sl_next == 2 * SLOTB) ? 0 : sl_next + SLOTB; vs_prev = vs_cur; vs_cur = vs_next; vs_next = vs_nn; vs_nn = (vs_nn == 3 * SLOTB) ? 0 : vs_nn + SLOTB; } while (0)
    if (!pre) DMA_K(2, 2 * SLOTB);
    WB_K2V2();
    qkt<KD>(pA0, pA1, kp0, qr, negm); asm volatile("s_nop 15\n\ts_nop 7" : "+v"(pA0), "+v"(pA1)); CMASK(pA0, pA1, 0);
    START(pA0, pA1);
#pragma unroll
    for (int r = 0; r < 16; ++r) pA1[r] = __builtin_amdgcn_exp2f(pA1[r]);
    NEXTBLK(0);
    WB_0();
    DMA_K(3, 0); DMA_V(2, 2 * SLOTB);
    ROT();
#pragma unroll
    for (int j = 0; j < KD; ++j) kload2(kf, kp0 + KO(sl_cur), j);
    WB_K1V1();
    s16x4 vlo[8], vhi[8]; u32x4_t pw0, pw1, pw2, pw3;
#define PKW(P, B) pk2(P[B], P[B + 1])
#define PAF(k) __builtin_bit_cast(bf16x8, pw##k)
#define VFR(i) (bf16x8){vlo[i][0], vlo[i][1], vlo[i][2], vlo[i][3], vhi[i][0], vhi[i][1], vhi[i][2], vhi[i][3]}
#define PIN(x) asm volatile("" : "+v"(x))
#define MX3(a, b, c) __builtin_fmaxf(__builtin_fmaxf((a), (b)), (c))
#define MF(a, b, c) __builtin_amdgcn_mfma_f32_32x32x16_bf16(a, b, c, 0, 0, 0)
#define GAPA(MFX, A0, A1, A2, A3, W0, W1, PW) do { MFX; sacc += A0; sacc += A1; sacc += A2; sacc += A3; PIN(sacc); W0; W1; PIN(PW); SBAR(); } while (0)
#define EX(v) __builtin_amdgcn_exp2f(v)
#define GAPB(MFX, X, B) do { MFX; X[B] = EX(X[B]); X[B + 1] = EX(X[B + 1]); X[B + 2] = EX(X[B + 2]); X[B + 3] = EX(X[B + 3]); PIN(X); SBAR(); } while (0)
#define VRD(i) do { vlo[i] = vtr(vp_ + (((i) >> 2) * 4096 + ((i) & 3) * 1024)); vhi[i] = vtr(vp_ + (((i) >> 2) * 4096 + ((i) & 3) * 1024 + 512)); } while (0)
#define KRD(G, j) do { if (G) { kload2(kf, kp0 + KO(sl_next), j); SBAR(); } } while (0)
#define STEP(C0, C1, P0, P1, t, GK, GV, GL) do { SBAR(); \
    const lds_cptr vp_ = vp0 + vs_prev; \
    VRD(0); SBAR(); float sacc = (P0[0] + P0[1]); \
    GAPA(C0 = MF(kf[0], qr[0], negm), P0[2], P0[3], P0[4], P0[5],     pw0[0] = PKW(P0, 0), pw0[1] = PKW(P0, 2), pw0); \
    VRD(4); SBAR(); GAPA(C1 = MF(kf[1], qr[0], negm), P0[6], P0[7], P0[8], P0[9],     pw0[2] = PKW(P0, 4), pw0[3] = PKW(P0, 6), pw0); \
    VRD(1); SBAR(); GAPA(C0 = MF(kf[2], qr[1], C0),   P0[10], P0[11], P0[12], P0[13], pw1[0] = PKW(P0, 8), pw1[1] = PKW(P0, 10), pw1); \
    VRD(5); SBAR(); GAPA(C1 = MF(kf[3], qr[1], C1),   P0[14], P0[15], P1[0], P1[1],   pw1[2] = PKW(P0, 12), pw1[3] = PKW(P0, 14), pw1); \
    VRD(2); SBAR(); GAPA(C0 = MF(kf[4], qr[2], C0),   P1[2], P1[3], P1[4], P1[5],     pw2[0] = PKW(P1, 0), pw2[1] = PKW(P1, 2), pw2); \
    VRD(6); SBAR(); GAPA(C1 = MF(kf[5], qr[2], C1),   P1[6], P1[7], P1[8], P1[9],     pw2[2] = PKW(P1, 4), pw2[3] = PKW(P1, 6), pw2); \
    VRD(3); SBAR(); GAPA(C0 = MF(kf[6], qr[3], C0),   P1[10], P1[11], P1[12], P1[13], pw3[0] = PKW(P1, 8), pw3[1] = PKW(P1, 10), pw3); \
    VRD(7); SBAR(); GAPA(C1 = MF(kf[7], qr[3], C1),   P1[14], P1[15], 0.f, 0.f,       pw3[2] = PKW(P1, 12), pw3[3] = PKW(P1, 14), pw3); \
    if constexpr (KD > 4) { C0 = MF(kf[8], qr[4], C0); SBAR(); C1 = MF(kf[9], qr[4], C1); SBAR(); } \
    if constexpr (KD > 5) { C0 = MF(kf[2 * KD - 2], qr[KD - 1], C0); SBAR(); C1 = MF(kf[2 * KD - 1], qr[KD - 1], C1); SBAR(); } \
    l_reg += sacc; \
    if (GK) { DMA_K((t) + 3, sl_cur); } if (GV) { DMA_V((t) + 2, vs_nn); } \
    CMASK(C0, C1, t); \
    { float a = MX3(C0[0], C0[1], C1[0]), b_ = MX3(C0[2], C0[3], C1[1]); a = MX3(a, C1[2], C1[3]); \
      _Pragma("unroll") for (int r = 4; r < 16; r += 4) { a = MX3(a, C0[r], C0[r + 1]); b_ = MX3(b_, C0[r + 2], C0[r + 3]); a = MX3(a, C1[r], C1[r + 1]); b_ = MX3(b_, C1[r + 2], C1[r + 3]); } \
      float rm = __builtin_fmaxf(a, b_); { auto rr = __builtin_amdgcn_permlane32_swap(__float_as_uint(rm), __float_as_uint(rm), false, false); rm = __builtin_fmaxf(__uint_as_float(rr[0]), __uint_as_float(rr[1])); } \
      resc = false; \
      if (__builtin_expect(__any(rm > (float)THRL), 0)) { const float dl = __builtin_fmaxf(rm, 0.f); mhat += dl; \
        _Pragma("unroll") for (int r = 0; r < 16; ++r) { C0[r] -= dl; C1[r] -= dl; } \
        _Pragma("unroll") for (int r = 0; r < 16; ++r) negm[r] = selneg - mhat; asm volatile("" : "+v"(negm)); \
        const float f = __builtin_amdgcn_exp2f(-dl); l_reg *= f; if (hi == 0) wsf[r32] = f; resc = true; } } \
    SBAR(); \
    GAPB(o[0] = MF(PAF(0), VFR(0), o[0]), C0, 0); \
    GAPB(o[1] = MF(PAF(0), VFR(4), o[1]), C0, 4); \
    KRD(GL, 0); GAPB(o[0] = MF(PAF(1), VFR(1), o[0]), C0, 8); \
    KRD(GL, 1); GAPB(o[1] = MF(PAF(1), VFR(5), o[1]), C0, 12); \
    KRD(GL, 2); GAPB(o[0] = MF(PAF(2), VFR(2), o[0]), C1, 0); \
    KRD(GL, 3); GAPB(o[1] = MF(PAF(2), VFR(6), o[1]), C1, 4); \
    if constexpr (KD > 4) KRD(GL, 4); GAPB(o[0] = MF(PAF(3), VFR(3), o[0]), C1, 8); \
    if constexpr (KD > 5) KRD(GL, 5); GAPB(o[1] = MF(PAF(3), VFR(7), o[1]), C1, 12); \
    NEXTBLK(t); \
    } while (0)
    int t = 1;
#define CMASK_FULL(P0, P1, t) do { if (MODE == 0) { const int jb_ = (t) - (NT - 4); if (jb_ >= 0) cmask(P0, P1, jb_, qrel, hi); } else { if ((t) + 6 >= NT) TBIAS(P0, P1, t); } } while (0)
#undef CMASK
#define CMASK(P0, P1, t) do { } while (0)
    for (; t + 7 < NT; t += 2) {
        STEP(pB0, pB1, pA0, pA1, t, true, true, true);     WB_K1V2(); RESC(); ROT();
        STEP(pA0, pA1, pB0, pB1, t + 1, true, true, true); WB_K1V2(); RESC(); ROT();
    }
#undef CMASK
#define CMASK(P0, P1, t) CMASK_FULL(P0, P1, t)
#define ENDW(tt) do { if ((tt) + 3 < NT) { WB_K1V2(); } else if ((tt) + 2 < NT) { WAIT_BAR(2); } else { WB_0(); } } while (0)
    for (; t + 1 < NT; t += 2) {
        STEP(pB0, pB1, pA0, pA1, t, (t + 3 < NT), (t + 2 < NT), (t + 1 < NT));         ENDW(t);     RESC(); ROT();
        STEP(pA0, pA1, pB0, pB1, t + 1, (t + 4 < NT), (t + 3 < NT), (t + 2 < NT));     ENDW(t + 1); RESC(); ROT();
    }
    if (nqb >= 0) {
        const long nd_ = (long)(nb - b) * SEQ; const bf16* ksn_ = ksrc + (long)(nb - b) * KBS; const bf16* vsn_ = vsrc + nd_ * vpitch; const bf16* krn_ = (KD == 6) ? uniform_ptr(KR + (long)nb * SEQ * 32) : nullptr; (void)krn_;
#define DMA_KN(t, slot) DMA_K2(ksn_, krn_, t, slot)
#define DMA_VN(t, slot) glds16(vsn_ + (long)(t) * 64 * vpitch, (unsigned)__builtin_amdgcn_readfirstlane(vdst + (slot)))
        DMA_KN(0, 0); DMA_VN(0, 0); DMA_KN(1, SLOTB); DMA_VN(1, SLOTB); DMA_KN(2, 2 * SLOTB);
#undef DMA_KN
#undef DMA_VN
    }
    STEP(pB0, pB1, pA0, pA1, NT - 1, false, false, false); RESC();
    { float sacc = pB0[0] + pB0[1];
#pragma unroll
      for (int r = 2; r < 16; ++r) sacc += pB0[r];
#pragma unroll
      for (int r = 0; r < 16; ++r) sacc += pB1[r];
      l_reg += sacc;
      pw0 = (u32x4_t){PKW(pB0, 0), PKW(pB0, 2), PKW(pB0, 4), PKW(pB0, 6)}; pw1 = (u32x4_t){PKW(pB0, 8), PKW(pB0, 10), PKW(pB0, 12), PKW(pB0, 14)};
      pw2 = (u32x4_t){PKW(pB1, 0), PKW(pB1, 2), PKW(pB1, 4), PKW(pB1, 6)}; pw3 = (u32x4_t){PKW(pB1, 8), PKW(pB1, 10), PKW(pB1, 12), PKW(pB1, 14)};
      SBAR(); pv(o, vb0 + vs_cur, PAF(0), PAF(1), PAF(2), PAF(3)); }
    l_reg = half_sum(l_reg);
    if (hi == 0) wsf[32 + r32] = l_reg; asm volatile("s_waitcnt lgkmcnt(0)" ::: "memory");
    float rli[16];
#pragma unroll
    for (int r = 0; r < 16; ++r) rli[r] = __builtin_amdgcn_rcpf(wsf[32 + crow(r, hi)]);
    bf16* Ow = O + (rowbase + q0 + wid * 32) * DM;
    { LAS unsigned short* stg = (LAS unsigned short*)(lds + LY::LDS_OST) + wid * 2048;
#pragma unroll
      for (int r = 0; r < 16; ++r) { const int orow = crow(r, hi);
#pragma unroll
          for (int d0 = 0; d0 < 2; ++d0) stg[orow * 64 + d0 * 32 + r32] = f2bf1(o[d0][r] * rli[r]); }
      asm volatile("s_waitcnt lgkmcnt(0)" ::: "memory");
#pragma unroll
      for (int i = 0; i < 4; ++i) { const int row = i * 8 + (lane >> 3), ch = lane & 7; const v4u v = *(const LAS v4u*)(stg + row * 64 + ch * 8); *(GAS v4u*)(Ow + (long)row * DM + ch * 8) = v;
          float ss; { const float a0 = __uint_as_float(v.x << 16), a1 = __uint_as_float(v.x & 0xffff0000u), a2 = __uint_as_float(v.y << 16), a3 = __uint_as_float(v.y & 0xffff0000u);
              const float a4 = __uint_as_float(v.z << 16), a5 = __uint_as_float(v.z & 0xffff0000u), a6 = __uint_as_float(v.w << 16), a7 = __uint_as_float(v.w & 0xffff0000u);
              ss = ((a0 * a0 + a1 * a1) + (a2 * a2 + a3 * a3)) + ((a4 * a4 + a5 * a5) + (a6 * a6 + a7 * a7)); }
          ss = sum8(ss);
          if (ch == 0) oss[(rowbase + q0 + 32 * wid + row) * 16] = ss; } }
    if (nqb >= 0) asm volatile("s_waitcnt lgkmcnt(0)\n\ts_barrier" ::: "memory");
    else asm volatile("s_waitcnt vmcnt(0) lgkmcnt(0)\n\ts_barrier" ::: "memory");
#undef KO
#undef DMA_K
#undef DMA_K2
#undef DMA_V
#undef SELNEG
#undef TBIAS
#undef CMASK
#undef CMASK_FULL
#undef START
#undef RESC
#undef NEXTBLK
#undef ROT
#undef PKW
#undef PAF
#undef VFR
#undef PIN
#undef MX3
#undef MF
#undef GAPA
#undef EX
#undef GAPB
#undef VRD
#undef KRD
#undef STEP
#undef ENDW
}
#undef SBAR
#undef WAIT_BAR
}
#define ATTN_TB att::Lay<4>::LDS_TB
struct RotOrder {
    pg8::StaticOrder S;
    __device__ void init(int M, int N, int G_, int c_) { S.init(M, N, G_, c_); }
    __device__ bool next(int i, pg8::Unit& u) const { if (!S.next(i, u)) return false; u.pn = (u.pn + (i >> 1)) & 7; return true; }
    __device__ __forceinline__ void a_ready(const pg8::Unit&) const {}
    __device__ __forceinline__ void done(const pg8::Unit&) const {}
};
struct Args { const float* in[19]; float* out; unsigned char* ws; int ph_lo, ph_hi, li, pad; };
constexpr int NPH_L = 10, NPH = 2 + NPH_L * NLAYER;

__global__ void __launch_bounds__(NTHR, 2) mk_fwd(Args args) {
    extern __shared__ __attribute__((aligned(16))) unsigned char lds_raw[];
    LAS unsigned char* lds = (LAS unsigned char*)lds_raw;
    volatile LAS unsigned* MISC = (volatile LAS unsigned*)(lds + MISC_OFF);
    const int tid0 = threadIdx.x;
    const int G = gridDim.x, bx = blockIdx.x, NGW = G * NWAVES;
    unsigned* ctl = (unsigned*)(args.ws + WS_CTL);
    for (int u = tid0; u < (LDS_BYTES - RING_BYTES) / 4; u += NTHR) ((LAS unsigned*)(lds + RING_BYTES))[u] = 0u;
    __syncthreads();
    XcdBarrier bar; bar.bar = ctl + CW_BAR + args.li * XCD_BAR_WORDS; bar.x = 0; bar.st = nullptr;
    if (MK_FUSED) bar = xcd_barrier_post(ctl + CW_BAR + args.li * XCD_BAR_WORDS, MISC + 8);
    const int lo = args.ph_lo, hi = args.ph_hi; (void)lo; (void)hi;
#ifndef PHMASK
#define PHMASK 0xffffffffu
#endif
#define IN(k) (lo <= (k) && (k) < hi)
#define PHON(i) ((PHMASK >> (i)) & 1u)
#define SEAM(k) do { if (IN(k) && IN((k) + 1)) xcd_barrier(bar); } while (0)

    typedef const Args __attribute__((address_space(4)))* ArgsP;
    unsigned char* ws0 = args.ws; ArgsP ap0 = (ArgsP)__builtin_amdgcn_kernarg_segment_ptr();
#define PHASE_BEGIN() unsigned char* wsp = ws0; ArgsP AP = ap0; int tid = tid0; asm volatile("" : "+s"(wsp), "+s"(AP), "+v"(tid)); \
    const int lane = tid & 63, wave = __builtin_amdgcn_readfirstlane(tid >> 6), gw = bx * NWAVES + wave; (void)lane; (void)gw
#define WSF(off) ((float*)ws_at(wsp, (off)))
#define WSB(off) ((bf16*)ws_at(wsp, (off)))
    if (PHON(0) && IN(0)) {
        PHASE_BEGIN(); float* CMOD = WSF(WS_CMOD); f32x2* ROPE = (f32x2*)ws_at(wsp, WS_ROPE); float* TB = WSF(WS_TB);
        LAS float* scr = (LAS float*)(lds + wave * 16384);
        for (int l = 0; l < NLAYER; ++l) {
            unsigned char* wl = ws_at(wsp, WS_W + l * W_LAYER);
#define PREP_MAT(W_, Ksrc_, Nsrc_, WT_, Kdst_, Ndst_, map_, ks_) do { const int nnb_ = (Ndst_) / 32, nit_ = ((Kdst_) / 64) * nnb_; \
                for (int it = gw; it < nit_; it += NGW) prep_item((W_), (Ksrc_), (Nsrc_), (WT_), (Kdst_), (map_), (ks_), scr, it / nnb_, it % nnb_, lane); } while (0)
            PREP_MAT(AP->in[7] + (size_t)l * DM * IN_W, DM, IN_W, (bf16*)ws_at(wl, WO_IN), DM, 2048, 0, (const float*)nullptr);
            PREP_MAT(AP->in[10] + (size_t)l * 256 * 768, 256, 768, (bf16*)ws_at(wl, WO_UQ), 256, 768, 1, AP->in[9] + l * 256);
            PREP_MAT(AP->in[12] + (size_t)l * 128 * 1024, 128, 1024, (bf16*)ws_at(wl, WO_UKV), 128, 1024, 1, AP->in[11] + l * 128);
            PREP_MAT(AP->in[14] + (size_t)l * DM * DM, DM, DM, (bf16*)ws_at(wl, WO_OUT), DM, DM, 1, AP->in[13] + l * DM);
            PREP_MAT(AP->in[17] + (size_t)l * DM * 2 * DFF, DM, 2 * DFF, (bf16*)ws_at(wl, WO_GU), DM, 2 * DFF, 2, (const float*)nullptr);
            if constexpr (PM8_L0 < 256 || PM8_L1 < 256) { PREP_MAT(AP->in[18] + (size_t)l * DFF * DM, DFF, DM, (bf16*)ws_at(wl, WO_DN), DFF, DM, 3, (const float*)nullptr); }
            for (int it = gw; it < (DFF / 64) * (DM / 32); it += NGW) prep_item8(AP->in[18] + (size_t)l * DFF * DM, DM, ws_at(wsp, WS_DN8 + l * DN8_LAYER), DFF, WDN_SC, scr, it / (DM / 32), it % (DM / 32), lane);
#undef PREP_MAT
        }
        __syncthreads();
        for (int i = bx * NTHR + tid; i < SEQ * 16; i += G * NTHR) { const int s = i >> 4, k = i & 15; float c, sn; sincos_acc((float)s * rope_invfreq(k), c, sn); ROPE[i] = (f32x2){c, sn}; }
        for (int i = bx * NTHR + tid; i < 4 * 132; i += G * NTHR) { const int h = i / 132, d = i % 132; const float* t5 = AP->in[2];
            WSF(WS_TB)[i] = (d < 128) ? (t5[t5_bucket_dev(d) * 4 + h] - t5[31 * 4 + h]) * LOG2E : 0.f; }
        for (int task = bx; task < NLAYER * 96; task += G) {
            const int l = task / 96, jc = task % 96;
            __syncthreads();
            LAS float* ca = (LAS float*)(lds + wave * 16384);
            for (int i = lane; i < 128 * 32; i += 64) { const int bb = i >> 7, kk = i & 127; const float cv = AP->in[1][bb * DM + wave * 128 + kk]; ca[kk * 32 + bb] = cv / (1.f + __expf(-cv)); }
            LDS_WAIT(); asm volatile("" ::: "memory");
            float accm[32];
#pragma unroll
            for (int i = 0; i < 32; ++i) accm[i] = 0.f;
            const float* wa = AP->in[3] + ((size_t)l * DM + wave * 128) * 6144 + jc * 64 + lane;
#pragma unroll 1
            for (int kk0 = 0; kk0 < 128; kk0 += 16) { float wq[16];
#pragma unroll
                for (int u = 0; u < 16; ++u) wq[u] = wa[(size_t)(kk0 + u) * 6144];
#pragma unroll
                for (int u = 0; u < 16; ++u) { const float w = wq[u];
#pragma unroll
                    for (int q4 = 0; q4 < 8; ++q4) { const f32x4 cv = *(const LAS f32x4*)(ca + (kk0 + u) * 32 + 4 * q4);
                        accm[4 * q4 + 0] += w * cv.x; accm[4 * q4 + 1] += w * cv.y; accm[4 * q4 + 2] += w * cv.z; accm[4 * q4 + 3] += w * cv.w; } } }
            __syncthreads();
            LAS float* red = (LAS float*)lds;
#pragma unroll
            for (int i = 0; i < 32; ++i) red[(wave * 32 + i) * 64 + lane] = accm[i];
            __syncthreads();
            for (int o = tid; o < 2048; o += NTHR) { const int bb = o >> 6, col = o & 63; float s = 0.f;
#pragma unroll
                for (int w = 0; w < 8; ++w) s += red[(w * 32 + bb) * 64 + col];
                const int j = jc * 64 + col, chunk = j >> 10, cc = j & 1023; const float mod = s + AP->in[4][l * 6144 + j];
                float r = mod;
                if (chunk == 1) r = AP->in[5][l * DM + cc] * (1.f + mod); else if (chunk == 2) r = mod * AP->in[6][l * DM + cc];
                else if (chunk == 4) r = AP->in[15][l * DM + cc] * (1.f + mod); else if (chunk == 5) r = mod * AP->in[16][l * DM + cc];
                CMOD[(((size_t)l * NB + bb) * 6 + chunk) * DM + cc] = r; }
        }
        __syncthreads();
    }
    SEAM(0);
    if (PHON(1) && IN(1)) { PHASE_BEGIN(); prenorm_rows(AP->in[0], WSF(WS_CMOD), 1, 0, WSB(WS_H), gw, NGW, lane); }
    SEAM(1);

    for (int l = 0; l < NLAYER; ++l) {
        const int pb = 2 + l * NPH_L;
        if (PHON(2) && IN(pb + 0)) { PHASE_BEGIN(); unsigned char* wl = ws_at(wsp, WS_W + l * W_LAYER); const float* cmod_l = WSF(WS_CMOD) + (size_t)l * NB * 6 * DM; (void)wl; (void)cmod_l;
            pg8::Gemm g{WSB(WS_H), (const bf16*)ws_at(wl, WO_IN), MTOK, 2048, DM}; RotOrder S; S.init(MTOK, 2048, G, bx);
            EpiInproj E{wsp, AP->in[8] + l * 4};
            pg8::gemm_phase<EpiInproj, RotOrder, true, true>(lds, g, S, E);
        }
        SEAM(pb + 0);
        if (PHON(3) && IN(pb + 1)) { PHASE_BEGIN(); unsigned char* wl = ws_at(wsp, WS_W + l * W_LAYER); const float* cmod_l = WSF(WS_CMOD) + (size_t)l * NB * 6 * DM; (void)wl; (void)cmod_l;
#ifndef P1_SEL
#define P1_SEL 7
#endif
            if (P1_SEL & 1) { fox_scan(WSF(WS_LOGF), WSF(WS_PSUM), WSB(WS_QF), WSB(WS_KF), gw, NGW, lane, (LAS float*)(lds + RING_BYTES + 9216 + wave * 256)  ); build_kmf(WSF(WS_KMP), WSB(WS_KMF), NGW - 1 - gw, NGW, lane); }
        }
        SEAM(pb + 1);
        if (PHON(4) && IN(pb + 2)) { PHASE_BEGIN(); unsigned char* wl = ws_at(wsp, WS_W + l * W_LAYER); const float* cmod_l = WSF(WS_CMOD) + (size_t)l * NB * 6 * DM; (void)wl; (void)cmod_l;
            const int vcu = (G % 8 == 0) ? (bx % 8) * (G / 8) + bx / 8 : bx;
#define UNIT_LIST(NP_, HEADS_, CALL_) do { const int npair_ = (vcu < (NP_)) ? ((NP_) - vcu + G - 1) / G : 0; \
                for (int u_ = 0; u_ < 2 * npair_; ++u_) { const int p = vcu + G * (u_ >> 1), bh = p >> 2, s = p & 3, b = bh / (HEADS_), h = bh % (HEADS_); const int qb = (u_ & 1) ? 7 - s : s; \
                    int nb = 0, nqb = -1; if (u_ + 1 < 2 * npair_) { const int p2 = vcu + G * ((u_ + 1) >> 1), bh2 = p2 >> 2, s2 = p2 & 3; if (bh2 % (HEADS_) == h) { nb = bh2 / (HEADS_); nqb = ((u_ + 1) & 1) ? 7 - s2 : s2; } } \
                    bool pre = false; if (u_ > 0) { const int p0 = vcu + G * ((u_ - 1) >> 1); pre = ((p0 >> 2) % (HEADS_)) == h; } \
                    CALL_; } } while (0)
            const bool gemm_first = ((vcu >> 2) & 1) != 0;
#pragma unroll 1
            for (int step = 0; step < 2; ++step) {
                if ((step == 0) == gemm_first) {
                if (P1_SEL & 2) { pg8::Gemm g{WSB(WS_CQ), (const bf16*)ws_at(wl, WO_UQ), MTOK, 768, 256}; pg8::StaticOrder S; S.init(MTOK, 768, G, bx);
                  EpiQup E{WSB(WS_QC), WSF(WS_CQSS), (const f32x2*)ws_at(wsp, WS_ROPE)}; pg8::gemm_phase<EpiQup, pg8::StaticOrder, true, true>(lds, g, S, E); }
                if (P1_SEL & 4) { pg8::Gemm g{WSB(WS_T7), (const bf16*)ws_at(wl, WO_UKV), MTOK, 1024, 128};   pg8::StaticOrder S; S.init(MTOK, 1024, G, bx);
                  EpiKVup E{WSB(WS_KC), WSB(WS_VC), WSF(WS_CKVSS)}; pg8::gemm_phase<EpiKVup, pg8::StaticOrder, true, true, false, true>(lds, g, S, E); }
                } else {
            UNIT_LIST(NB * 4 * 4, 4, (att::attn_unit_t<5, 0, 8, 4 * SEQ * 80, 80>(WSB(WS_QF) + h * 80, 320, WSB(WS_KF) + h * (SEQ * 80), WSB(WS_VF) + h * 64, 256, WSB(WS_O) + h * 64, b, qb, lds, nullptr, WSF(WS_OSS) + h, pre, nb, nqb)));
            int tb_h = -1;
            UNIT_LIST(NB * 4 * 4, 4, ({ if (h != tb_h) { __syncthreads(); if (tid < 256) { const int d = 191 - tid; ((LAS float*)(lds + ATTN_TB))[tid] = d < 0 ? -INFINITY : (d < 128 ? WSF(WS_TB)[h * 132 + d] : 0.f); } __syncthreads(); tb_h = h; }
                att::attn_unit_t<4, 1, 8, SEQ * 256, 256>(WSB(WS_QM) + h * 64, 256, WSB(WS_KM) + h * 64, WSB(WS_VM) + h * 64, 256, WSB(WS_O) + 256 + h * 64, b, qb, lds, (const float*)(WSB(WS_KMF) + (size_t)(b * 4 + h) * 4096), WSF(WS_OSS) + 4 + h, pre, nb, nqb); }));
                }
            }
#undef UNIT_LIST
        }
        SEAM(pb + 2);
        if (PHON(5) && IN(pb + 3)) { PHASE_BEGIN(); unsigned char* wl = ws_at(wsp, WS_W + l * W_LAYER); const float* cmod_l = WSF(WS_CMOD) + (size_t)l * NB * 6 * DM; (void)wl; (void)cmod_l;
            const int vcu = (G % 8 == 0) ? (bx % 8) * (G / 8) + bx / 8 : bx;
#define UNIT_LIST(NP_, HEADS_, CALL_) do { const int npair_ = (vcu < (NP_)) ? ((NP_) - vcu + G - 1) / G : 0; \
                for (int u_ = 0; u_ < 2 * npair_; ++u_) { const int p = vcu + G * (u_ >> 1), bh = p >> 2, s = p & 3, b = bh / (HEADS_), h = bh % (HEADS_); const int qb = (u_ & 1) ? 7 - s : s; \
                    int nb = 0, nqb = -1; if (u_ + 1 < 2 * npair_) { const int p2 = vcu + G * ((u_ + 1) >> 1), bh2 = p2 >> 2, s2 = p2 & 3; if (bh2 % (HEADS_) == h) { nb = bh2 / (HEADS_); nqb = ((u_ + 1) & 1) ? 7 - s2 : s2; } } \
                    bool pre = false; if (u_ > 0) { const int p0 = vcu + G * ((u_ - 1) >> 1); pre = ((p0 >> 2) % (HEADS_)) == h; } \
                    CALL_; } } while (0)
            UNIT_LIST(NB * 8 * 4, 8, (att::attn_unit_t<6, 0, 8, 8 * SEQ * 64, 64>(WSB(WS_QC) + h * 96, 768, WSB(WS_KC) + h * (SEQ * 64), WSB(WS_VC) + h * 64, 512, WSB(WS_O) + 512 + h * 64, b, qb, lds, nullptr, WSF(WS_OSS) + 8 + h, pre, nb, nqb, WSB(WS_KR))));
#undef UNIT_LIST
        }
        SEAM(pb + 3);
        if (PHON(7) && IN(pb + 5)) {
          { PHASE_BEGIN(); pg8::StaticOrder S; S.init(MTOK, DM, G, bx);
            for (int i0 = 0; ; i0 += 2) { pg8::Unit ua, ub; if (!S.next(i0, ua)) break;
                const bool hb = S.next(i0 + 1, ub);
                const int pmu = (wave >> 2) ? (hb ? ub.pm : -1) : ua.pm; if (pmu < 0) continue;
                const int m = pmu * 256 + (tid & 255);
                const GAS f32x4* sp = (const GAS f32x4*)(WSF(WS_OSS) + (size_t)m * 16); const f32x4 a = sp[0], c = sp[1], d = sp[2], e = sp[3];
                const float r0 = fast_rsqrt(((a.x + a.y) + (a.z + a.w)) * (1.f / 256.f) + RMS_EPS), r1 = fast_rsqrt(((c.x + c.y) + (c.z + c.w)) * (1.f / 256.f) + RMS_EPS);
                const float r2 = fast_rsqrt((((d.x + d.y) + (d.z + d.w)) + ((e.x + e.y) + (e.z + e.w))) * (1.f / 512.f) + RMS_EPS);
                *(GAS f32x4*)(WSF(WS_F) + (size_t)m * 4) = (f32x4){r0 / r1, r1 / r2, r2, 0.f}; }
            asm volatile("s_waitcnt vmcnt(0)" ::: "memory"); __syncthreads();
          }
          { PHASE_BEGIN(); unsigned char* wl = ws_at(wsp, WS_W + l * W_LAYER); const float* cmod_l = WSF(WS_CMOD) + (size_t)l * NB * 6 * DM; (void)wl; (void)cmod_l;
            pg8::Gemm g{WSB(WS_O), (const bf16*)ws_at(wl, WO_OUT), MTOK, DM, DM}; pg8::StaticOrder S; S.init(MTOK, DM, G, bx);
            EpiYks E{WSB(WS_Y), WSF(WS_YSS), WSF(WS_F), (LAS float*)(lds + RING_BYTES + 1024)}; pg8::gemm_phase<EpiYks, pg8::StaticOrder, true, true>(lds, g, S, E);
          }
        }
        SEAM(pb + 5);
        if (PHON(8) && IN(pb + 6)) { PHASE_BEGIN(); unsigned char* wl = ws_at(wsp, WS_W + l * W_LAYER); const float* cmod_l = WSF(WS_CMOD) + (size_t)l * NB * 6 * DM; (void)wl; (void)cmod_l;
            if (l == 0) post_rows<false, true>(AP->in[0], WSB(WS_XB), WSB(WS_Y), WSF(WS_YSS), RMS_EPS, cmod_l, 2, true, cmod_l, 4, 3, WSB(WS_H), gw, NGW, lane);
            else post_rows<true, true>(WSB(WS_XB), WSB(WS_XB), WSB(WS_Y), WSF(WS_YSS), RMS_EPS, cmod_l, 2, true, cmod_l, 4, 3, WSB(WS_H), gw, NGW, lane); }
        SEAM(pb + 6);
        if (PHON(9) && IN(pb + 7)) { PHASE_BEGIN(); unsigned char* wl = ws_at(wsp, WS_W + l * W_LAYER); const float* cmod_l = WSF(WS_CMOD) + (size_t)l * NB * 6 * DM; (void)wl; (void)cmod_l;
            pg8::Gemm g{WSB(WS_H), (const bf16*)ws_at(wl, WO_GU), MTOK, 2 * DFF, DM}; pg8::StaticOrder S; S.init(MTOK, 2 * DFF, G, bx);
            EpiSwiglu E{WSB(WS_ACT), ws_at(wsp, WS_ACT8), l == 0 ? PM8_L0 : PM8_L1}; pg8::gemm_phase<EpiSwiglu, pg8::StaticOrder, true, true>(lds, g, S, E);
        }
        SEAM(pb + 7);
        if (PHON(10) && IN(pb + 8)) { PHASE_BEGIN(); unsigned char* wl = ws_at(wsp, WS_W + l * W_LAYER); const float* cmod_l = WSF(WS_CMOD) + (size_t)l * NB * 6 * DM; (void)wl; (void)cmod_l;
            const int m8 = (l == 0 ? PM8_L0 : PM8_L1) * 256;
            if (m8 > 0) { pg8::Gemm g{(const bf16*)ws_at(wsp, WS_ACT8), (const bf16*)ws_at(wsp, WS_DN8 + l * DN8_LAYER), m8, DM, DFF / 2}; pg8::StaticOrder S; S.init(m8, DM, G, bx);
                EpiY E{WSB(WS_Y), WSF(WS_YSS)}; pg8::gemm_phase<EpiY, pg8::StaticOrder, true, true, true>(lds, g, S, E); }
            if (m8 < MTOK) { pg8::Gemm g{WSB(WS_ACT) + (size_t)m8 * DFF, (const bf16*)ws_at(wl, WO_DN), MTOK - m8, DM, DFF}; pg8::StaticOrder S; S.init(MTOK - m8, DM, G, bx);
                EpiY E{WSB(WS_Y) + (size_t)m8 * DM, WSF(WS_YSS) + (size_t)m8 * 16}; pg8::gemm_phase<EpiY, pg8::StaticOrder, true, true>(lds, g, S, E); }
        }
        SEAM(pb + 8);
        if (PHON(11) && IN(pb + 9)) { PHASE_BEGIN(); unsigned char* wl = ws_at(wsp, WS_W + l * W_LAYER); const float* cmod_l = WSF(WS_CMOD) + (size_t)l * NB * 6 * DM; (void)wl; (void)cmod_l;
            if (l + 1 < NLAYER) post_rows<true, true>(WSB(WS_XB), WSB(WS_XB), WSB(WS_Y), WSF(WS_YSS), RMS_EPS / (DN_OSC * DN_OSC), cmod_l, 5, true, cmod_l + (size_t)NB * 6 * DM, 1, 0, WSB(WS_H), gw, NGW, lane);
            else post_rows<true, false>(WSB(WS_XB), AP->out, WSB(WS_Y), WSF(WS_YSS), RMS_EPS / (DN_OSC * DN_OSC), cmod_l, 5, false, cmod_l, 1, 0, WSB(WS_H), gw, NGW, lane); }
        SEAM(pb + 9);
    }
#undef IN
#undef SEAM
}

extern "C" void kernel_launch(void* const* d_in, const int* in_sizes, int n_in, void* d_out, int out_size, void* d_ws, size_t ws_size, hipStream_t stream) {
    static int grid = 0;
    if (grid == 0) {
        if (n_in != 19 || in_sizes[0] != MTOK * DM || out_size != MTOK * DM || ws_size < WS_END) { fprintf(stderr, "kernel_launch: unexpected shapes / workspace (n_in %d, ws %zu); nothing launched\n", n_in, ws_size); grid = -1; return; }
        int dev = 0, cus = 0, per_cu = 0;
        if (hipGetDevice(&dev) != hipSuccess || hipDeviceGetAttribute(&cus, hipDeviceAttributeMultiprocessorCount, dev) != hipSuccess) { grid = -1; return; }
        if (hipFuncSetAttribute((const void*)mk_fwd, hipFuncAttributeMaxDynamicSharedMemorySize, LDS_BYTES) != hipSuccess) { fprintf(stderr, "kernel_launch: hipFuncSetAttribute failed\n"); grid = -1; return; }
        if (hipOccupancyMaxActiveBlocksPerMultiprocessor(&per_cu, (const void*)mk_fwd, NTHR, LDS_BYTES) != hipSuccess || per_cu < 1) { fprintf(stderr, "kernel_launch: occupancy query reports %d\n", per_cu); }
        (void)hipGetLastError();
        grid = cus;
    }
    if (grid < 0) return;
    if (hipMemsetAsync((char*)d_ws + WS_CTL, 0, CTL_ZERO_BYTES, stream) != hipSuccess) return;
    Args a{};
    for (int i = 0; i < 19; ++i) a.in[i] = (const float*)d_in[i];
    a.out = (float*)d_out; a.ws = (unsigned char*)d_ws; a.pad = 0;
#if MK_FUSED
    a.ph_lo = 0; a.ph_hi = NPH; a.li = 0;
    hipLaunchKernelGGL(mk_fwd, dim3(grid), dim3(NTHR), LDS_BYTES, stream, a);
#else
#ifndef PROBE_REPMASK
#define PROBE_REPMASK 0u
#endif
    for (int p = 0; p < NPH; ++p) { const int reps = ((PROBE_REPMASK >> p) & 1u) ? 2 : 1;
        for (int r = 0; r < reps; ++r) { a.ph_lo = p; a.ph_hi = p + 1; a.li = 0; hipLaunchKernelGGL(mk_fwd, dim3(grid), dim3(NTHR), LDS_BYTES, stream, a); } }
#endif
}
```
